# Optimizing an MI355X kernel written in HIP

```python
import jax, jax.numpy as jnp
from jax import lax
import numpy as np

D_MODEL = 2048
BATCH = 4
SEQ = 2048
DEPTH = 1

CHUNK = 64
PLE_DIM = 256
EPS = 1e-6

MIX_A = D_MODEL // 2
CONV_GROUPS = 8
CONV_WIDTH = 3

MIX_B = D_MODEL // 2
GLA_HEADS = 4
GLA_DK_TOTAL = MIX_B // 2
GLA_DK = GLA_DK_TOTAL // GLA_HEADS
GLA_DV = MIX_B // GLA_HEADS
GLA_GATE_RANK = 16
GLA_TAU = 16.0

D_FF = ((8 * D_MODEL // 3 + 255) // 256) * 256

IN_SPLITS = (MIX_A, MIX_A, MIX_A,
             GLA_DK_TOTAL, GLA_DK_TOTAL, MIX_B, MIX_B, GLA_GATE_RANK,
             D_MODEL, D_MODEL)
IN_COLS = sum(IN_SPLITS)

kernel_name = "hybrid_shortconv_gla_gated_merge_block"


def rms_norm(x, gain):
    xf = x.astype(jnp.float32)
    y = xf * lax.rsqrt(jnp.mean(xf * xf, axis=-1, keepdims=True) + EPS)
    return (y * gain.astype(jnp.float32)).astype(x.dtype)


def short_conv_branch(u_x, u_b, u_c, conv_w, w_out):
    u = u_c * u_x
    y = lax.conv_general_dilated(
        u, conv_w[:, None, :].astype(u.dtype), window_strides=(1,),
        padding=[(CONV_WIDTH - 1, 0)],
        dimension_numbers=('NWC', 'WIO', 'NWC'),
        feature_group_count=MIX_A)
    return (u_b * y) @ w_out


def gla_branch(q, k, v, og, a_lr, w_alpha_up, b_alpha_up, head_gain, w_out):
    out_dtype = v.dtype
    bsz, seq = q.shape[0], q.shape[1]
    n = seq // CHUNK
    f32 = jnp.float32
    z = a_lr.astype(f32) @ w_alpha_up.astype(f32) + b_alpha_up.astype(f32)
    log_a = jax.nn.log_sigmoid(z) / GLA_TAU
    shp_k = (bsz, n, CHUNK, GLA_HEADS, GLA_DK)
    q = q.astype(f32).reshape(shp_k) * (GLA_DK ** -0.5)
    k = k.astype(f32).reshape(shp_k)
    v = v.astype(f32).reshape(bsz, n, CHUNK, GLA_HEADS, GLA_DV)
    b = jnp.cumsum(log_a.reshape(shp_k), axis=2)
    b_last = b[:, :, -1:]
    mid = b[:, :, CHUNK // 2:CHUNK // 2 + 1]
    a_fwd = jnp.einsum('bnthd,bnshd->bnhts', q * jnp.exp(b - mid), k * jnp.exp(mid - b))
    a_rev = jnp.einsum('bnthd,bnshd->bnhts', q * jnp.exp(mid - b), k * jnp.exp(b - mid))
    lower = jnp.tril(jnp.ones((CHUNK, CHUNK), dtype=bool))
    att = jnp.where(lower, a_fwd, a_rev)
    o_intra = jnp.einsum('bnhts,bnshv->bnthv', att, v)
    u_c = jnp.einsum('bnshd,bnshv->bnhdv', k * jnp.exp(b_last - b), v)
    decay = jnp.exp(b_last[:, :, 0])

    def step(state, inp):
        dec, upd = inp
        return dec[..., None] * state + upd, state

    s0 = jnp.zeros((bsz, GLA_HEADS, GLA_DK, GLA_DV), f32)
    _, s_in = lax.scan(step, s0, (jnp.moveaxis(decay, 1, 0), jnp.moveaxis(u_c, 1, 0)))
    s_in = jnp.moveaxis(s_in, 0, 1)
    o_inter = jnp.einsum('bnthd,bnhdv->bnthv', q * jnp.exp(b), s_in)
    o = (o_intra + o_inter).reshape(bsz, seq, GLA_HEADS, GLA_DV)
    o = o * lax.rsqrt(jnp.mean(o * o, axis=-1, keepdims=True) + EPS) * head_gain.astype(f32)
    o = o.reshape(bsz, seq, MIX_B) * jax.nn.silu(og.astype(f32))
    return o.astype(out_dtype) @ w_out


def setup_inputs(seed: int = 0) -> dict:
    key = jax.random.key(seed)
    ks = jax.random.split(key, 24)
    f32 = jnp.float32

    def nrm(k, shape, scale):
        return jax.random.normal(k, shape, f32) * scale

    def gain(k, dim):
        return 1.0 + 0.05 * jax.random.normal(k, (DEPTH, dim), f32)

    return {
        "x": nrm(ks[0], (BATCH, SEQ, D_MODEL), 1.0),
        "p": nrm(ks[1], (DEPTH, BATCH, SEQ, PLE_DIM), 1.0),
        "w_in": nrm(ks[2], (DEPTH, D_MODEL, IN_COLS), D_MODEL ** -0.5),
        "conv_w": nrm(ks[3], (DEPTH, CONV_WIDTH, MIX_A), CONV_WIDTH ** -0.5),
        "w_a_out": nrm(ks[4], (DEPTH, MIX_A, D_MODEL), MIX_A ** -0.5),
        "w_alpha_up": nrm(ks[5], (DEPTH, GLA_GATE_RANK, GLA_DK_TOTAL), GLA_GATE_RANK ** -0.5),
        "b_alpha_up": nrm(ks[6], (DEPTH, GLA_DK_TOTAL), 0.1),
        "gla_head_gain": gain(ks[7], GLA_DV),
        "w_b_out": nrm(ks[8], (DEPTH, MIX_B, D_MODEL), MIX_B ** -0.5),
        "w_mix_out": nrm(ks[9], (DEPTH, D_MODEL, D_MODEL), D_MODEL ** -0.5),
        "g_pre_mix": gain(ks[10], D_MODEL),
        "g_post_mix": gain(ks[11], D_MODEL),
        "g_pre_ffn": gain(ks[12], D_MODEL),
        "g_post_ffn": gain(ks[13], D_MODEL),
        "w_ff_gate": nrm(ks[14], (DEPTH, D_MODEL, D_FF), D_MODEL ** -0.5),
        "w_ff_up": nrm(ks[15], (DEPTH, D_MODEL, D_FF), D_MODEL ** -0.5),
        "w_ff_down": nrm(ks[16], (DEPTH, D_FF, D_MODEL), D_FF ** -0.5),
        "g_pre_ple": gain(ks[17], D_MODEL),
        "g_post_ple": gain(ks[18], D_MODEL),
        "w_ple_gate": nrm(ks[19], (DEPTH, D_MODEL, D_MODEL), D_MODEL ** -0.5),
        "w_ple_proj": nrm(ks[20], (DEPTH, PLE_DIM, D_MODEL), PLE_DIM ** -0.5),
    }


def reference(x, p, w_in, conv_w, w_a_out, w_alpha_up, b_alpha_up, gla_head_gain,
              w_b_out, w_mix_out, g_pre_mix, g_post_mix, g_pre_ffn, g_post_ffn,
              w_ff_gate, w_ff_up, w_ff_down, g_pre_ple, g_post_ple,
              w_ple_gate, w_ple_proj):
    split_idx = [int(c) for c in np.cumsum(IN_SPLITS)[:-1]]
    for i in range(DEPTH):
        h = rms_norm(x, g_pre_mix[i])
        proj = h @ w_in[i]
        (a_x, a_b, a_c, q, k, v, og, a_lr, gate_a, gate_b) = jnp.split(proj, split_idx, axis=-1)
        y_a = short_conv_branch(a_x, a_b, a_c, conv_w[i], w_a_out[i])
        y_b = gla_branch(q, k, v, og, a_lr, w_alpha_up[i], b_alpha_up[i],
                         gla_head_gain[i], w_b_out[i])
        mix = jax.nn.sigmoid(gate_a) * y_a + jax.nn.sigmoid(gate_b) * y_b
        x = x + rms_norm(mix @ w_mix_out[i], g_post_mix[i])
        h = rms_norm(x, g_pre_ffn[i])
        f = (jax.nn.silu(h @ w_ff_gate[i]) * (h @ w_ff_up[i])) @ w_ff_down[i]
        x = x + rms_norm(f, g_post_ffn[i])
        h = rms_norm(x, g_pre_ple[i])
        e = jax.nn.sigmoid(h @ w_ple_gate[i]) * (p[i] @ w_ple_proj[i])
        x = x + rms_norm(e, g_post_ple[i])
    return x
```

```cpp
#include <hip/hip_runtime.h>
#include <hip/hip_cooperative_groups.h>
#include <cstdio>
namespace cg = cooperative_groups;

#define LAS __attribute__((address_space(3)))
typedef unsigned short bf16_t;
typedef short bf16x8 __attribute__((ext_vector_type(8)));
typedef float f32x4 __attribute__((ext_vector_type(4)));
typedef unsigned u32x4 __attribute__((ext_vector_type(4)));
typedef unsigned u32x2 __attribute__((ext_vector_type(2)));

constexpr int M_ = 8192, D_ = 2048, SEQ_ = 2048, NPROJ = 10240, FF_ = 5632, NFF1 = 11264, WIN_LD = 10256;
constexpr int C_AX = 0, C_AB = 1024, C_AC = 2048, C_Q = 3072, C_K = 3584, C_V = 4096, C_OG = 5120, C_GA = 6144, C_GB = 8192;
constexpr float EPS_ = 1e-6f;
constexpr int LDS_BYTES = 131072;

constexpr size_t WS_WIN = 0;
constexpr size_t WS_WAO = WS_WIN + (size_t)NPROJ * 2048 * 2;
constexpr size_t WS_WBO = WS_WAO + (size_t)2048 * 1024 * 2;
constexpr size_t WS_WMIX = WS_WBO + (size_t)2048 * 1024 * 2;
constexpr size_t WS_WFF1 = WS_WMIX + (size_t)2048 * 2048 * 2;
constexpr size_t WS_WDN = WS_WFF1 + (size_t)NFF1 * 2048 * 2;
constexpr size_t WS_WPG = WS_WDN + (size_t)2048 * FF_ * 2;
constexpr size_t WS_WPP = WS_WPG + (size_t)2048 * 2048 * 2;
constexpr size_t WS_H = WS_WPP + (size_t)2048 * 256 * 2;
constexpr size_t WS_PROJ = WS_H + (size_t)M_ * 2048 * 2;
constexpr size_t WS_ALR = WS_PROJ + (size_t)M_ * NPROJ * 2;
constexpr size_t WS_DEC = WS_ALR + (size_t)M_ * 16 * 4;
constexpr size_t WS_PART = WS_DEC + (size_t)512 * 128 * 4;
constexpr size_t WS_PBF = WS_PART + (size_t)M_ * 32 * 4;
constexpr size_t WS_END = WS_PBF + (size_t)M_ * 256 * 2;
constexpr size_t WS_T = WS_PROJ;
constexpr size_t WS_GU = WS_PROJ + (size_t)64 * 1024 * 1024;

__device__ __forceinline__ unsigned pk2(float lo, float hi) { unsigned r; asm("v_cvt_pk_bf16_f32 %0, %1, %2" : "=v"(r) : "v"(lo), "v"(hi)); return r; }
__device__ __forceinline__ float bflo(unsigned w) { return __uint_as_float(w << 16); }
__device__ __forceinline__ float bfhi(unsigned w) { return __uint_as_float(w & 0xffff0000u); }
__device__ __forceinline__ float bf2f(bf16_t b) { return __uint_as_float(((unsigned)b) << 16); }
__device__ __forceinline__ float sigmoidf_(float x) { return __builtin_amdgcn_rcpf(1.0f + __expf(-x)); }
__device__ __forceinline__ float wave_sum(float v) {
#pragma unroll
    for (int o = 1; o < 64; o <<= 1) v += __shfl_xor(v, o);
    return v;
}
__device__ __forceinline__ float dot4(f32x4 a, f32x4 b) { return (a.x * b.x + a.y * b.y) + (a.z * b.z + a.w * b.w); }
__device__ __forceinline__ void unpack8(u32x4 w, float (&f)[8]) {
    f[0] = bflo(w.x); f[1] = bfhi(w.x); f[2] = bflo(w.y); f[3] = bfhi(w.y); f[4] = bflo(w.z); f[5] = bfhi(w.z); f[6] = bflo(w.w); f[7] = bfhi(w.w);
}
__device__ __forceinline__ bf16x8 pack8(const float (&f)[8]) {
    u32x4 w; w.x = pk2(f[0], f[1]); w.y = pk2(f[2], f[3]); w.z = pk2(f[4], f[5]); w.w = pk2(f[6], f[7]);
    return __builtin_bit_cast(bf16x8, w);
}
#define LDS_WAIT() asm volatile("s_waitcnt lgkmcnt(0)" ::: "memory")

namespace pg8 {
constexpr int BM = 256, BK = 64, HALF = 128, HTB = HALF * BK * 2, NXCD = 8, WGM = 8;
__device__ __forceinline__ int lds_byte(int r, int c) { const int st = (r >> 4) * 2 + (c >> 5), rr = r & 15, cc = c & 31, ob = rr * 64 + cc * 2; return st * 1024 + (ob ^ (((ob >> 9) & 1) << 5)); }
__device__ __forceinline__ void stage_rc(int b, int& R, int& C) { const int st = b / 1024, sb = b % 1024, swz = sb ^ (((sb >> 9) & 1) << 5); R = (st >> 1) * 16 + swz / 64; C = (st & 1) * 32 + (swz % 64) / 2; }
__device__ __forceinline__ int perm32(int rho) { const int n = rho >> 4, i = rho & 15; return 8 * (i >> 2) + 4 * n + (i & 3); }

struct Unit { int pm, pn; };
struct Gemm { const bf16_t* A; const bf16_t* Bt; int lda, ldb, M, N, K; };

struct StaticOrder {
    int nM, nN, nwg, G, c;
    __device__ void init(int M, int N, int G_, int c_) { nM = M / BM; nN = N / BM; nwg = nM * nN; G = G_; c = c_; }
    __device__ bool next(int i, Unit& u) const {
        const long L = (long)i * G + c; if (L >= nwg) return false;
        int wgid = (int)L; { const int q = nwg / NXCD, r = nwg % NXCD, xcd = wgid % NXCD, off = wgid / NXCD; wgid = (xcd < r ? xcd * (q + 1) : r * (q + 1) + (xcd - r) * q) + off; }
        const int nig = WGM * nN, gid = wgid / nig, fm = gid * WGM, gsz = (nM - fm) < WGM ? (nM - fm) : WGM;
        u.pm = fm + ((wgid % nig) % gsz); u.pn = (wgid % nig) / gsz; return true;
    }
};

template <class Epi>
__device__ __forceinline__ void gemm_phase(LAS unsigned char* lds, const Gemm g, const StaticOrder& S, const Epi& E) {
    const int tid = threadIdx.x, wid = __builtin_amdgcn_readfirstlane(tid >> 6), lane = tid & 63, wr = wid >> 2, wc = wid & 3, fr = lane & 15, fq = lane >> 4;
    const int K = g.K, nt = K / BK;
    unsigned voffA[2], voffB[2];
#pragma unroll
    for (int i = 0; i < 2; ++i) { int R, C; stage_rc(tid * 16 + i * 8192, R, C); const int Rb = Epi::PERM ? ((R & ~31) + perm32(R & 31)) : R;
        voffA[i] = (unsigned)(R * g.lda + C) * 2u; voffB[i] = (unsigned)(Rb * g.ldb + C) * 2u; }
    const size_t kstep = (size_t)(BK * 2);
    const size_t hstepA = (size_t)HALF * g.lda * 2, hstepB = (size_t)HALF * g.ldb * 2;
    const size_t tstepA = 2 * hstepA, tstepB = 2 * hstepB;
    const unsigned ldsw = (unsigned)wid * 1024u;
    const int aoff = lds_byte(wr * 64 + fr, fq * 8), boff = lds_byte(wc * 32 + fr, fq * 8);
#define PG8_SA(b, h) (((b) * 2 + (h)) * HTB)
#define PG8_SB(b, h) ((4 + (b) * 2 + (h)) * HTB)
#define PG8_STAGE(bufoff, gbase, voff) do { _Pragma("unroll") for (int _i = 0; _i < 2; ++_i) \
        __builtin_amdgcn_global_load_lds((const unsigned*)((const char*)(gbase) + (voff)[_i]), (LAS unsigned*)(lds + (bufoff) + ldsw + _i * 8192), 16, 0, 0); } while (0)
#define PG8_LDA(dst, b, h) do { _Pragma("unroll") for (int m = 0; m < 4; ++m) _Pragma("unroll") for (int k = 0; k < 2; ++k) dst[m][k] = *(const LAS bf16x8*)(lds + PG8_SA(b, h) + aoff + m * 2048 + k * 1024); } while (0)
#define PG8_LDB(dst, b, h) do { _Pragma("unroll") for (int n = 0; n < 2; ++n) _Pragma("unroll") for (int k = 0; k < 2; ++k) dst[n][k] = *(const LAS bf16x8*)(lds + PG8_SB(b, h) + boff + n * 2048 + k * 1024); } while (0)
#define PG8_MMA(ai, bj, At, Bt) do { __builtin_amdgcn_s_setprio(1); _Pragma("unroll") for (int m = 0; m < 4; ++m) _Pragma("unroll") for (int n = 0; n < 2; ++n) _Pragma("unroll") for (int k = 0; k < 2; ++k) \
        acc[ai][bj][m][n] = __builtin_amdgcn_mfma_f32_16x16x32_bf16(Bt[n][k], At[m][k], acc[ai][bj][m][n], 0, 0, 0); __builtin_amdgcn_s_setprio(0); } while (0)
#define PG8_WAIT_V(n) asm volatile("s_waitcnt vmcnt(" #n ")" ::: "memory")
#define PG8_WAIT_L(n) asm volatile("s_waitcnt lgkmcnt(" #n ")" ::: "memory")
#define PG8_BAR __builtin_amdgcn_s_barrier()
#define PG8_SCHED __builtin_amdgcn_sched_barrier(0)
    Unit cur, nxt; int ui = 0;
    if (!S.next(0, cur)) return;
    f32x4 acc[2][2][4][2];
#pragma unroll
    for (int a = 0; a < 2; ++a)
#pragma unroll
        for (int b = 0; b < 2; ++b)
#pragma unroll
            for (int m = 0; m < 4; ++m)
#pragma unroll
                for (int n = 0; n < 2; ++n) acc[a][b][m][n] = (f32x4){0.f, 0.f, 0.f, 0.f};
    bf16x8 At[4][2], B0[2][2], B1[2][2];
    const char* cA = (const char*)g.A + (size_t)cur.pm * tstepA; const char* cB = (const char*)g.Bt + (size_t)cur.pn * tstepB;
    PG8_STAGE(PG8_SB(0, 0), cB, voffB); PG8_STAGE(PG8_SA(0, 0), cA, voffA); PG8_STAGE(PG8_SB(0, 1), cB + hstepB, voffB); PG8_STAGE(PG8_SA(0, 1), cA + hstepA, voffA);
    if (wr == 1) PG8_BAR;
    PG8_WAIT_V(4); PG8_BAR;
    PG8_STAGE(PG8_SB(1, 0), cB + kstep, voffB); PG8_STAGE(PG8_SA(1, 0), cA + kstep, voffA); PG8_STAGE(PG8_SB(1, 1), cB + hstepB + kstep, voffB);
    PG8_WAIT_V(6); PG8_BAR;
    for (;;) {
        const bool has_next = S.next(ui + 1, nxt);
        const char* nA = has_next ? (const char*)g.A + (size_t)nxt.pm * tstepA : cA; const char* nB = has_next ? (const char*)g.Bt + (size_t)nxt.pn * tstepB : cB;
        for (int t = 0; t < nt; t += 2) {
            const bool last = (t == nt - 2);
            const char* a1 = cA + (size_t)(t + 1) * kstep;
            const char* a2 = last ? nA : cA + (size_t)(t + 2) * kstep; const char* b2 = last ? nB : cB + (size_t)(t + 2) * kstep;
            const char* a3 = a2 + kstep; const char* b3 = b2 + kstep;
            PG8_LDB(B0, 0, 0); PG8_SCHED; PG8_LDA(At, 0, 0); PG8_STAGE(PG8_SA(1, 1), a1 + hstepA, voffA);
            PG8_WAIT_L(8); PG8_BAR; PG8_WAIT_L(0); PG8_MMA(0, 0, At, B0); PG8_BAR; PG8_SCHED;
            PG8_LDB(B1, 0, 1); PG8_STAGE(PG8_SB(0, 0), b2, voffB);
            PG8_BAR; PG8_WAIT_L(0); PG8_MMA(0, 1, At, B1); PG8_BAR;
            PG8_LDA(At, 0, 1); PG8_STAGE(PG8_SA(0, 0), a2, voffA);
            PG8_BAR; PG8_WAIT_L(0); PG8_MMA(1, 0, At, B0); PG8_BAR; PG8_SCHED;
            PG8_STAGE(PG8_SB(0, 1), b2 + hstepB, voffB);
            PG8_WAIT_V(6); PG8_BAR; PG8_MMA(1, 1, At, B1); PG8_BAR;
            PG8_LDB(B0, 1, 0); PG8_SCHED; PG8_LDA(At, 1, 0); PG8_STAGE(PG8_SA(0, 1), a2 + hstepA, voffA);
            PG8_WAIT_L(8); PG8_BAR; PG8_WAIT_L(0); PG8_MMA(0, 0, At, B0); PG8_BAR; PG8_SCHED;
            PG8_LDB(B1, 1, 1); PG8_STAGE(PG8_SB(1, 0), b3, voffB);
            PG8_BAR; PG8_WAIT_L(0); PG8_MMA(0, 1, At, B1); PG8_BAR;
            PG8_LDA(At, 1, 1); PG8_STAGE(PG8_SA(1, 0), a3, voffA);
            PG8_BAR; PG8_WAIT_L(0); PG8_MMA(1, 0, At, B0); PG8_BAR; PG8_SCHED;
            PG8_STAGE(PG8_SB(1, 1), b3 + hstepB, voffB);
            PG8_WAIT_V(6); PG8_BAR; PG8_MMA(1, 1, At, B1); PG8_BAR;
        }
        E(acc, cur.pm, cur.pn, wr, wc, fr, fq);
        if (!has_next) break;
#pragma unroll
        for (int a = 0; a < 2; ++a)
#pragma unroll
            for (int b = 0; b < 2; ++b)
#pragma unroll
                for (int m = 0; m < 4; ++m)
#pragma unroll
                    for (int n = 0; n < 2; ++n) acc[a][b][m][n] = (f32x4){0.f, 0.f, 0.f, 0.f};
        cur = nxt; cA = nA; cB = nB; ++ui;
    }
    PG8_WAIT_V(0);
    if (wr == 0) PG8_BAR;
    PG8_BAR;
#undef PG8_SA
#undef PG8_SB
#undef PG8_STAGE
#undef PG8_LDA
#undef PG8_LDB
#undef PG8_MMA
#undef PG8_WAIT_V
#undef PG8_WAIT_L
#undef PG8_BAR
#undef PG8_SCHED
}
}

enum { EP_BF16 = 0, EP_GATE = 1, EP_GATEADD = 2, EP_F32PART = 3, EP_SWIGLU = 4, EP_F32 = 5, EP_SIGMUL = 6 };
template <int MODE> struct Epi {
    static constexpr bool PERM = (MODE == EP_BF16 || MODE == EP_GATE || MODE == EP_GATEADD || MODE == EP_SWIGLU);
    void* out; int ldo;
    const void* aux; int ldaux;
    float* tmp;
    float* part;
    __device__ __forceinline__ void operator()(const f32x4 (&acc)[2][2][4][2], int pm, int pn, int wr, int wc, int fr, int fq) const {
        const int row0 = pm * 256 + wr * 64 + fr;
        const int cl = 32 * wc + (PERM ? 8 * fq : 4 * fq);
#pragma unroll
        for (int ai = 0; ai < 2; ++ai)
#pragma unroll
        for (int m = 0; m < 4; ++m) {
            const size_t r = (size_t)(row0 + ai * 128 + m * 16);
            if constexpr (MODE == EP_SWIGLU) {
                u32x4 w; unsigned ww[4];
#pragma unroll
                for (int n = 0; n < 2; ++n) { const f32x4 g = acc[ai][0][m][n], u = acc[ai][1][m][n]; float v[4];
#pragma unroll
                    for (int j = 0; j < 4; ++j) v[j] = g[j] * sigmoidf_(g[j]) * u[j];
                    ww[2 * n] = pk2(v[0], v[1]); ww[2 * n + 1] = pk2(v[2], v[3]); }
                w.x = ww[0]; w.y = ww[1]; w.z = ww[2]; w.w = ww[3];
                *(u32x4*)((bf16_t*)out + r * ldo + pn * 128 + cl) = w;
            } else {
                float ss = 0.f;
#pragma unroll
                for (int bj = 0; bj < 2; ++bj) {
                    const int c = pn * 256 + bj * 128 + cl;
                    if constexpr (MODE == EP_BF16) {
                        const f32x4 a0 = acc[ai][bj][m][0], a1 = acc[ai][bj][m][1]; u32x4 w;
                        w.x = pk2(a0[0], a0[1]); w.y = pk2(a0[2], a0[3]); w.z = pk2(a1[0], a1[1]); w.w = pk2(a1[2], a1[3]);
                        *(u32x4*)((bf16_t*)out + r * ldo + c) = w;
                    } else if constexpr (MODE == EP_GATE || MODE == EP_GATEADD) {
                        const u32x4 gw = *(const u32x4*)((const bf16_t*)aux + r * ldaux + c); float gt[8]; unpack8(gw, gt);
                        f32x4 v0, v1; const f32x4 a0 = acc[ai][bj][m][0], a1 = acc[ai][bj][m][1];
#pragma unroll
                        for (int j = 0; j < 4; ++j) { v0[j] = a0[j] * sigmoidf_(gt[j]); v1[j] = a1[j] * sigmoidf_(gt[4 + j]); }
                        float* tp = tmp + r * 2048 + c;
                        if constexpr (MODE == EP_GATE) { *(f32x4*)tp = v0; *(f32x4*)(tp + 4) = v1; }
                        else { const f32x4 t0 = *(const f32x4*)tp, t1 = *(const f32x4*)(tp + 4); v0 += t0; v1 += t1; u32x4 w;
                            w.x = pk2(v0[0], v0[1]); w.y = pk2(v0[2], v0[3]); w.z = pk2(v1[0], v1[1]); w.w = pk2(v1[2], v1[3]);
                            *(u32x4*)((bf16_t*)out + r * ldo + c) = w; }
                    } else {
#pragma unroll
                        for (int n = 0; n < 2; ++n) { f32x4 a = acc[ai][bj][m][n]; float* op = (float*)out + r * ldo + c + 16 * n;
                            if constexpr (MODE == EP_SIGMUL) { const f32x4 t = *(const f32x4*)((const float*)aux + r * ldaux + c + 16 * n);
#pragma unroll
                                for (int j = 0; j < 4; ++j) a[j] = sigmoidf_(a[j]) * t[j]; }
                            *(f32x4*)op = a;
                            if constexpr (MODE != EP_F32) ss += dot4(a, a); }
                    }
                }
                if constexpr (MODE == EP_F32PART || MODE == EP_SIGMUL) {
                    ss += __shfl_xor(ss, 16); ss += __shfl_xor(ss, 32);
                    if (fq == 0) part[r * 32 + pn * 4 + wc] = ss;
                }
            }
        }
    }
};

struct Params {
    const float *x, *p, *w_in, *conv_w, *w_a_out, *w_alpha_up, *b_alpha_up, *head_gain, *w_b_out, *w_mix_out,
                *g_pre_mix, *g_post_mix, *g_pre_ffn, *g_post_ffn, *w_ff_gate, *w_ff_up, *w_ff_down, *g_pre_ple, *g_post_ple, *w_ple_gate, *w_ple_proj;
    float* out; unsigned char* ws;
};

__device__ __forceinline__ void tr_item(const float* src, int ld_src, bf16_t* dst, int ldd, LAS float* scr, int lane) {
#pragma unroll 8
    for (int i = 0; i < 32; ++i) { const int kk = 2 * i + (lane >> 5); scr[kk * 33 + (lane & 31)] = src[(size_t)kk * ld_src + (lane & 31)]; }
    LDS_WAIT();
    const int c = lane & 7;
#pragma unroll
    for (int j = 0; j < 4; ++j) { const int n = (lane >> 3) + 8 * j; const LAS float* s = scr + (8 * c) * 33 + n;
        u32x4 o; o.x = pk2(s[0 * 33], s[1 * 33]); o.y = pk2(s[2 * 33], s[3 * 33]); o.z = pk2(s[4 * 33], s[5 * 33]); o.w = pk2(s[6 * 33], s[7 * 33]);
        *(u32x4*)(dst + (size_t)n * ldd + 8 * c) = o; }
    LDS_WAIT();
}

__device__ __forceinline__ void row_pass(const float* T, const float* part, const float* xin, float* xout, bf16_t* H, const float* gpost, const float* gpre, int m, int lane) {
    f32x4 v[8];
    const f32x4* xr = (const f32x4*)(xin + (size_t)m * D_) + lane;
    if (T) {
        float ps = lane < 32 ? part[(size_t)m * 32 + lane] : 0.f;
        const float rs = rsqrtf(wave_sum(ps) * (1.0f / D_) + EPS_);
        const f32x4* tr = (const f32x4*)(T + (size_t)m * D_) + lane; const f32x4* gp = (const f32x4*)gpost + lane;
#pragma unroll
        for (int j = 0; j < 8; ++j) { const f32x4 t = tr[64 * j], xv = xr[64 * j], g = gp[64 * j]; v[j] = xv + t * rs * g; }
    } else {
#pragma unroll
        for (int j = 0; j < 8; ++j) v[j] = xr[64 * j];
    }
    if (xout) { f32x4* xo = (f32x4*)(xout + (size_t)m * D_) + lane;
#pragma unroll
        for (int j = 0; j < 8; ++j) xo[64 * j] = v[j]; }
    if (H) {
        float s = 0.f;
#pragma unroll
        for (int j = 0; j < 8; ++j) s += dot4(v[j], v[j]);
        const float rs = rsqrtf(wave_sum(s) * (1.0f / D_) + EPS_);
        const f32x4* gq = (const f32x4*)gpre + lane; u32x2* ho = (u32x2*)(H + (size_t)m * D_) + lane;
#pragma unroll
        for (int j = 0; j < 8; ++j) { const f32x4 g = gq[64 * j]; const f32x4 h = v[j] * rs * g; u32x2 w; w.x = pk2(h[0], h[1]); w.y = pk2(h[2], h[3]); ho[64 * j] = w; }
    }
}

constexpr int GL_A = 0;
constexpr int GL_B = 4096;
constexpr int GL_V = GL_B + 64 * 132 * 4;
constexpr int GL_K = GL_V + 64 * 264 * 2;
constexpr int GL_RS = GL_K + 64 * 136 * 2;
static_assert(GL_RS + 2048 + 256 <= LDS_BYTES, "GLA LDS");

__device__ __forceinline__ void gla_bc(const float* ALR, const float* w_up, const float* b_up, int m0, int h, LAS float* sA, LAS float* sB, int tid) {
    if (tid < 256) { const f32x4 v = *(const f32x4*)(ALR + (size_t)m0 * 16 + tid * 4); *(LAS f32x4*)(sA + tid * 4) = v; }
    __syncthreads();
    const int d = tid & 127, seg = tid >> 7;
    float w[16];
#pragma unroll
    for (int r = 0; r < 16; ++r) w[r] = w_up[r * 512 + h * 128 + d];
    const float bias = b_up[h * 128 + d];
    float run = 0.f;
#pragma unroll 4
    for (int i = 0; i < 16; ++i) { const int t = seg * 16 + i; float z = bias;
#pragma unroll
        for (int r4 = 0; r4 < 4; ++r4) { const f32x4 a = *(const LAS f32x4*)(sA + t * 16 + r4 * 4); z += a.x * w[4 * r4] + a.y * w[4 * r4 + 1] + a.z * w[4 * r4 + 2] + a.w * w[4 * r4 + 3]; }
        const float ls = fminf(z, 0.f) - __logf(1.0f + __expf(-fabsf(z)));
        run += ls * (1.0f / 16.0f); sB[t * 132 + d] = run; }
    __syncthreads();
    float off = 0.f;
    for (int s = 0; s < seg; ++s) off += sB[(16 * s + 15) * 132 + d];
    __syncthreads();
    if (seg > 0) {
#pragma unroll 4
        for (int i = 0; i < 16; ++i) sB[(seg * 16 + i) * 132 + d] += off; }
    __syncthreads();
}

__global__ void __launch_bounds__(512, 2) mega_fwd(Params P) {
    extern __shared__ __attribute__((aligned(16))) unsigned char lds_raw[];
    LAS unsigned char* lds = (LAS unsigned char*)lds_raw;
    cg::grid_group grid = cg::this_grid();
    const int tid = threadIdx.x, lane = tid & 63, wave = __builtin_amdgcn_readfirstlane(tid >> 6);
    const int G = gridDim.x, bid = blockIdx.x;
    const int gw = bid * 8 + wave, NGW = G * 8;
    const int gtid = bid * 512 + tid, NT = G * 512;
    unsigned char* ws = P.ws;
    bf16_t* WT_in = (bf16_t*)(ws + WS_WIN); bf16_t* WT_ao = (bf16_t*)(ws + WS_WAO); bf16_t* WT_bo = (bf16_t*)(ws + WS_WBO); bf16_t* WT_mix = (bf16_t*)(ws + WS_WMIX);
    bf16_t* WT_ff1 = (bf16_t*)(ws + WS_WFF1); bf16_t* WT_dn = (bf16_t*)(ws + WS_WDN); bf16_t* WT_pg = (bf16_t*)(ws + WS_WPG); bf16_t* WT_pp = (bf16_t*)(ws + WS_WPP);
    bf16_t* Hb = (bf16_t*)(ws + WS_H); bf16_t* PROJ = (bf16_t*)(ws + WS_PROJ); float* ALR = (float*)(ws + WS_ALR); float* DEC = (float*)(ws + WS_DEC);
    float* PART = (float*)(ws + WS_PART); bf16_t* PBF = (bf16_t*)(ws + WS_PBF);
    bf16_t* MIX = (bf16_t*)(ws + WS_WIN); float* Tb = (float*)(ws + WS_T); bf16_t* GU = (bf16_t*)(ws + WS_GU); float* TMP2 = (float*)(ws + WS_GU);
    float* UT = P.out;
    float* TMP = P.out;

    {
        LAS float* scr = (LAS float*)(lds + wave * 8448);
        constexpr int I_IN = 32 * 320, I_AO = 16 * 64, I_MIX = 32 * 64, I_FF1 = 32 * 352, I_DN = 88 * 64, I_PG = 32 * 64, I_PP = 4 * 64;
        constexpr int NITEMS = I_IN + 2 * I_AO + I_MIX + I_FF1 + I_DN + I_PG + I_PP;
        for (int it = gw; it < NITEMS; it += NGW) {
            int r = it;
            if (r < I_IN) { const int kb = r / 320, nb = r % 320, n0 = 32 * nb, sc = n0 < 6144 ? n0 : n0 + 16;
                tr_item(P.w_in + (size_t)kb * 64 * WIN_LD + sc, WIN_LD, WT_in + (size_t)n0 * 2048 + kb * 64, 2048, scr, lane); continue; } r -= I_IN;
            if (r < I_AO) { const int kb = r / 64, nb = r % 64; tr_item(P.w_a_out + (size_t)kb * 64 * 2048 + 32 * nb, 2048, WT_ao + (size_t)32 * nb * 1024 + kb * 64, 1024, scr, lane); continue; } r -= I_AO;
            if (r < I_AO) { const int kb = r / 64, nb = r % 64; tr_item(P.w_b_out + (size_t)kb * 64 * 2048 + 32 * nb, 2048, WT_bo + (size_t)32 * nb * 1024 + kb * 64, 1024, scr, lane); continue; } r -= I_AO;
            if (r < I_MIX) { const int kb = r / 64, nb = r % 64; tr_item(P.w_mix_out + (size_t)kb * 64 * 2048 + 32 * nb, 2048, WT_mix + (size_t)32 * nb * 2048 + kb * 64, 2048, scr, lane); continue; } r -= I_MIX;
            if (r < I_FF1) { const int kb = r / 352, nb = r % 352, n0 = 32 * nb, pn = n0 >> 8, w = n0 & 255;
                const float* src = (w < 128 ? P.w_ff_gate : P.w_ff_up) + (size_t)kb * 64 * FF_ + 128 * pn + (w & 127);
                tr_item(src, FF_, WT_ff1 + (size_t)n0 * 2048 + kb * 64, 2048, scr, lane); continue; } r -= I_FF1;
            if (r < I_DN) { const int kb = r / 64, nb = r % 64; tr_item(P.w_ff_down + (size_t)kb * 64 * 2048 + 32 * nb, 2048, WT_dn + (size_t)32 * nb * FF_ + kb * 64, FF_, scr, lane); continue; } r -= I_DN;
            if (r < I_PG) { const int kb = r / 64, nb = r % 64; tr_item(P.w_ple_gate + (size_t)kb * 64 * 2048 + 32 * nb, 2048, WT_pg + (size_t)32 * nb * 2048 + kb * 64, 2048, scr, lane); continue; } r -= I_PG;
            { const int kb = r / 64, nb = r % 64; tr_item(P.w_ple_proj + (size_t)kb * 64 * 2048 + 32 * nb, 2048, WT_pp + (size_t)32 * nb * 256 + kb * 64, 256, scr, lane); }
        }
        for (int i = gtid; i < M_ * 256 / 8; i += NT) { const f32x4 a = *(const f32x4*)(P.p + (size_t)i * 8), b = *(const f32x4*)(P.p + (size_t)i * 8 + 4);
            u32x4 w; w.x = pk2(a[0], a[1]); w.y = pk2(a[2], a[3]); w.z = pk2(b[0], b[1]); w.w = pk2(b[2], b[3]); *(u32x4*)(PBF + (size_t)i * 8) = w; }
        __syncthreads();
        LAS float* sW = (LAS float*)lds;
        for (int i = 0; i < 16; ++i) { const int idx = tid + 512 * i, k = idx >> 2, r4 = idx & 3;
            const f32x4 v = *(const f32x4*)(P.w_in + (size_t)k * WIN_LD + 6144 + 4 * r4);
            sW[(4 * r4 + 0) * 2048 + k] = v.x; sW[(4 * r4 + 1) * 2048 + k] = v.y; sW[(4 * r4 + 2) * 2048 + k] = v.z; sW[(4 * r4 + 3) * 2048 + k] = v.w; }
        __syncthreads();
        for (int m = gw; m < M_; m += NGW) {
            const f32x4* xr = (const f32x4*)(P.x + (size_t)m * D_) + lane; const f32x4* gq = (const f32x4*)P.g_pre_mix + lane;
            f32x4 v[8]; float s = 0.f;
#pragma unroll
            for (int j = 0; j < 8; ++j) { v[j] = xr[64 * j]; s += dot4(v[j], v[j]); }
            const float rs = rsqrtf(wave_sum(s) * (1.0f / D_) + EPS_);
            u32x2* ho = (u32x2*)(Hb + (size_t)m * D_) + lane;
#pragma unroll
            for (int j = 0; j < 8; ++j) { const f32x4 g = gq[64 * j]; v[j] = v[j] * rs * g; u32x2 w; w.x = pk2(v[j][0], v[j][1]); w.y = pk2(v[j][2], v[j][3]); ho[64 * j] = w; }
            float mine = 0.f;
#pragma unroll
            for (int r = 0; r < 16; ++r) { float a = 0.f;
#pragma unroll
                for (int j = 0; j < 8; ++j) { const f32x4 wv = *(const LAS f32x4*)(sW + r * 2048 + 4 * lane + 256 * j); a += dot4(v[j], wv); }
                a = wave_sum(a); mine = (lane == r) ? a : mine; }
            if (lane < 16) ALR[(size_t)m * 16 + lane] = mine;
        }
    }
    grid.sync();

    {
        pg8::Gemm g{Hb, WT_in, 2048, 2048, M_, NPROJ, 2048}; pg8::StaticOrder S; S.init(M_, NPROJ, G, bid);
        Epi<EP_BF16> E{PROJ, NPROJ, nullptr, 0, nullptr, nullptr};
        pg8::gemm_phase(lds, g, S, E);
    }
    grid.sync();

    {
        bf16_t* AB = Hb;
        for (int idx = gtid; idx < M_ * 128; idx += NT) {
            const int m = idx >> 7, c = (idx & 127) * 8, t = m & (SEQ_ - 1);
            const bf16_t* pr = PROJ + (size_t)m * NPROJ;
            float u0[8], u1[8], u2[8], ab[8], tmpv[8];
            { u32x4 a = *(const u32x4*)(pr + C_AX + c), cc = *(const u32x4*)(pr + C_AC + c); unpack8(a, u0); unpack8(cc, tmpv);
#pragma unroll
              for (int i = 0; i < 8; ++i) u0[i] *= tmpv[i]; }
            if (t >= 1) { u32x4 a = *(const u32x4*)(pr - NPROJ + C_AX + c), cc = *(const u32x4*)(pr - NPROJ + C_AC + c); unpack8(a, u1); unpack8(cc, tmpv);
#pragma unroll
              for (int i = 0; i < 8; ++i) u1[i] *= tmpv[i]; }
            else {
#pragma unroll
              for (int i = 0; i < 8; ++i) u1[i] = 0.f; }
            if (t >= 2) { u32x4 a = *(const u32x4*)(pr - 2 * NPROJ + C_AX + c), cc = *(const u32x4*)(pr - 2 * NPROJ + C_AC + c); unpack8(a, u2); unpack8(cc, tmpv);
#pragma unroll
              for (int i = 0; i < 8; ++i) u2[i] *= tmpv[i]; }
            else {
#pragma unroll
              for (int i = 0; i < 8; ++i) u2[i] = 0.f; }
            { u32x4 b = *(const u32x4*)(pr + C_AB + c); unpack8(b, ab); }
            float y[8];
#pragma unroll
            for (int i4 = 0; i4 < 2; ++i4) { const f32x4 w0 = *(const f32x4*)(P.conv_w + c + 4 * i4), w1 = *(const f32x4*)(P.conv_w + 1024 + c + 4 * i4), w2 = *(const f32x4*)(P.conv_w + 2048 + c + 4 * i4);
#pragma unroll
                for (int j = 0; j < 4; ++j) { const int i = 4 * i4 + j; y[i] = ab[i] * (w0[j] * u2[i] + w1[j] * u1[i] + w2[j] * u0[i]); } }
            *(bf16x8*)(AB + (size_t)m * 2048 + c) = pack8(y);
        }
        LAS float* sA = (LAS float*)(lds + GL_A); LAS float* sB = (LAS float*)(lds + GL_B);
        LAS bf16_t* sV = (LAS bf16_t*)(lds + GL_V); LAS bf16_t* sK = (LAS bf16_t*)(lds + GL_K);
        const int fr = lane & 15, fq = lane >> 4;
        for (int item = bid; item < 512; item += G) {
            const int h = item & 3, bn = item >> 2, m0 = bn * 64;
            gla_bc(ALR, P.w_alpha_up, P.b_alpha_up, m0, h, sA, sB, tid);
#pragma unroll
            for (int it = 0; it < 2; ++it) { const int idx = tid + 512 * it, s = idx >> 4, g8 = (idx & 15) * 8;
                const u32x4 kw = *(const u32x4*)(PROJ + (size_t)(m0 + s) * NPROJ + C_K + h * 128 + g8); float kf[8]; unpack8(kw, kf);
#pragma unroll
                for (int i = 0; i < 8; ++i) kf[i] *= __expf(sB[63 * 132 + g8 + i] - sB[s * 132 + g8 + i]);
                *(LAS bf16x8*)(sK + s * 136 + g8) = pack8(kf); }
#pragma unroll
            for (int it = 0; it < 4; ++it) { const int idx = tid + 512 * it, s = idx >> 5, g8 = (idx & 31) * 8;
                *(LAS u32x4*)(sV + s * 264 + g8) = *(const u32x4*)(PROJ + (size_t)(m0 + s) * NPROJ + C_V + h * 256 + g8); }
            if (tid < 128) DEC[(size_t)item * 128 + tid] = __expf(sB[63 * 132 + tid]);
            __syncthreads();
            bf16x8 Bk[2];
#pragma unroll
            for (int ks = 0; ks < 2; ++ks) {
#pragma unroll
                for (int i = 0; i < 8; ++i) Bk[ks][i] = (short)sK[(ks * 32 + fq * 8 + i) * 136 + 16 * wave + fr]; }
            float* ut = UT + (size_t)item * 32768;
#pragma unroll 2
            for (int mt = 0; mt < 16; ++mt) {
                f32x4 acc = {0.f, 0.f, 0.f, 0.f};
#pragma unroll
                for (int ks = 0; ks < 2; ++ks) { bf16x8 Av;
#pragma unroll
                    for (int i = 0; i < 8; ++i) Av[i] = (short)sV[(ks * 32 + fq * 8 + i) * 264 + 16 * mt + fr];
                    acc = __builtin_amdgcn_mfma_f32_16x16x32_bf16(Av, Bk[ks], acc, 0, 0, 0); }
#pragma unroll
                for (int j = 0; j < 4; ++j) ut[(16 * mt + fq * 4 + j) * 128 + 16 * wave + fr] = acc[j];
            }
            __syncthreads();
        }
    }
    grid.sync();

    {
        for (int e = gtid; e < 16 * 32768; e += NT) {
            const int bh = e >> 15, rem = e & 32767, b = bh >> 2, h = bh & 3, d = rem & 127;
            float st = 0.f;
#pragma unroll 8
            for (int n = 0; n < 32; ++n) { const int item = (b * 32 + n) * 4 + h; float* p = UT + (size_t)item * 32768 + rem;
                const float u = *p, dec = DEC[item * 128 + d]; *p = st; st = dec * st + u; }
        }
    }
    grid.sync();

    {
        bf16_t* AB = Hb;
        LAS float* sA = (LAS float*)(lds + GL_A); LAS float* sB = (LAS float*)(lds + GL_B);
        LAS bf16_t* sV = (LAS bf16_t*)(lds + GL_V); LAS bf16_t* sT = (LAS bf16_t*)(lds + GL_K);
        LAS float* sRS = (LAS float*)(lds + GL_RS); LAS float* sR = (LAS float*)(lds + GL_RS + 2048);
        const int fr = lane & 15, fq = lane >> 4;
        const float scale = 0.08838834764831845f;
        for (int item = bid; item < 512; item += G) {
            const int h = item & 3, bn = item >> 2, m0 = bn * 64;
            gla_bc(ALR, P.w_alpha_up, P.b_alpha_up, m0, h, sA, sB, tid);
#pragma unroll
            for (int it = 0; it < 4; ++it) { const int idx = tid + 512 * it, s = idx >> 5, g8 = (idx & 31) * 8;
                *(LAS u32x4*)(sV + s * 264 + g8) = *(const u32x4*)(PROJ + (size_t)(m0 + s) * NPROJ + C_V + h * 256 + g8); }
            {
                const int tt = wave & 3, sp = wave >> 2;
                f32x4 af[2], ar[2];
#pragma unroll
                for (int i = 0; i < 2; ++i) { af[i] = (f32x4){0.f, 0.f, 0.f, 0.f}; ar[i] = (f32x4){0.f, 0.f, 0.f, 0.f}; }
#pragma unroll
                for (int kk = 0; kk < 4; ++kk) {
                    const int d0 = kk * 32 + fq * 8, t = 16 * tt + fr;
                    float mid[8], qf[8], qr[8];
                    { const f32x4 a = *(const LAS f32x4*)(sB + 32 * 132 + d0), b = *(const LAS f32x4*)(sB + 32 * 132 + d0 + 4);
                      mid[0] = a.x; mid[1] = a.y; mid[2] = a.z; mid[3] = a.w; mid[4] = b.x; mid[5] = b.y; mid[6] = b.z; mid[7] = b.w; }
                    { const u32x4 qw = *(const u32x4*)(PROJ + (size_t)(m0 + t) * NPROJ + C_Q + h * 128 + d0); float q[8]; unpack8(qw, q);
                      const f32x4 a = *(const LAS f32x4*)(sB + t * 132 + d0), b = *(const LAS f32x4*)(sB + t * 132 + d0 + 4);
                      const float bt[8] = {a.x, a.y, a.z, a.w, b.x, b.y, b.z, b.w};
#pragma unroll
                      for (int i = 0; i < 8; ++i) { const float qs = q[i] * scale; qf[i] = qs * __expf(bt[i] - mid[i]); qr[i] = qs * __expf(mid[i] - bt[i]); } }
                    const bf16x8 Af = pack8(qf), Ar = pack8(qr);
#pragma unroll
                    for (int s2 = 0; s2 < 2; ++s2) {
                        const int s = 16 * (2 * sp + s2) + fr; float kf[8], kr[8];
                        const u32x4 kw = *(const u32x4*)(PROJ + (size_t)(m0 + s) * NPROJ + C_K + h * 128 + d0); float k[8]; unpack8(kw, k);
                        const f32x4 a = *(const LAS f32x4*)(sB + s * 132 + d0), b = *(const LAS f32x4*)(sB + s * 132 + d0 + 4);
                        const float bs[8] = {a.x, a.y, a.z, a.w, b.x, b.y, b.z, b.w};
#pragma unroll
                        for (int i = 0; i < 8; ++i) { kf[i] = k[i] * __expf(mid[i] - bs[i]); kr[i] = k[i] * __expf(bs[i] - mid[i]); }
                        af[s2] = __builtin_amdgcn_mfma_f32_16x16x32_bf16(Af, pack8(kf), af[s2], 0, 0, 0);
                        ar[s2] = __builtin_amdgcn_mfma_f32_16x16x32_bf16(Ar, pack8(kr), ar[s2], 0, 0, 0);
                    }
                }
#pragma unroll
                for (int s2 = 0; s2 < 2; ++s2)
#pragma unroll
                    for (int j = 0; j < 4; ++j) { const int t = 16 * tt + fq * 4 + j, s = 16 * (2 * sp + s2) + fr;
                        const float v = (s <= t) ? af[s2][j] : ar[s2][j];
                        sT[t * 72 + s] = (bf16_t)(pk2(v, 0.f) & 0xffffu); }
            }
            __syncthreads();
            f32x4 o[4][2];
#pragma unroll
            for (int a = 0; a < 4; ++a)
#pragma unroll
                for (int b = 0; b < 2; ++b) o[a][b] = (f32x4){0.f, 0.f, 0.f, 0.f};
#pragma unroll
            for (int ks = 0; ks < 2; ++ks) {
                bf16x8 Bv[2];
#pragma unroll
                for (int v2 = 0; v2 < 2; ++v2)
#pragma unroll
                    for (int i = 0; i < 8; ++i) Bv[v2][i] = (short)sV[(ks * 32 + fq * 8 + i) * 264 + 16 * (2 * wave + v2) + fr];
#pragma unroll
                for (int tt = 0; tt < 4; ++tt) { const bf16x8 Aa = *(const LAS bf16x8*)(sT + (16 * tt + fr) * 72 + ks * 32 + fq * 8);
#pragma unroll
                    for (int v2 = 0; v2 < 2; ++v2) o[tt][v2] = __builtin_amdgcn_mfma_f32_16x16x32_bf16(Aa, Bv[v2], o[tt][v2], 0, 0, 0); }
            }
            const float* ut = UT + (size_t)item * 32768;
#pragma unroll
            for (int kk = 0; kk < 4; ++kk) {
                const int d0 = kk * 32 + fq * 8;
                bf16x8 Bs[2];
#pragma unroll
                for (int v2 = 0; v2 < 2; ++v2) { const float* sp = ut + (16 * (2 * wave + v2) + fr) * 128 + d0; const f32x4 a = *(const f32x4*)sp, b = *(const f32x4*)(sp + 4);
                    const float f[8] = {a.x, a.y, a.z, a.w, b.x, b.y, b.z, b.w}; Bs[v2] = pack8(f); }
#pragma unroll
                for (int tt = 0; tt < 4; ++tt) { const int t = 16 * tt + fr;
                    const u32x4 qw = *(const u32x4*)(PROJ + (size_t)(m0 + t) * NPROJ + C_Q + h * 128 + d0); float q[8]; unpack8(qw, q);
                    const f32x4 a = *(const LAS f32x4*)(sB + t * 132 + d0), b = *(const LAS f32x4*)(sB + t * 132 + d0 + 4);
                    const float bt[8] = {a.x, a.y, a.z, a.w, b.x, b.y, b.z, b.w};
#pragma unroll
                    for (int i = 0; i < 8; ++i) q[i] = q[i] * scale * __expf(bt[i]);
                    const bf16x8 Aq = pack8(q);
#pragma unroll
                    for (int v2 = 0; v2 < 2; ++v2) o[tt][v2] = __builtin_amdgcn_mfma_f32_16x16x32_bf16(Aq, Bs[v2], o[tt][v2], 0, 0, 0); }
            }
#pragma unroll
            for (int tt = 0; tt < 4; ++tt)
#pragma unroll
                for (int j = 0; j < 4; ++j) { float p = o[tt][0][j] * o[tt][0][j] + o[tt][1][j] * o[tt][1][j];
                    p += __shfl_xor(p, 1); p += __shfl_xor(p, 2); p += __shfl_xor(p, 4); p += __shfl_xor(p, 8);
                    if (fr == 0) sRS[wave * 64 + 16 * tt + fq * 4 + j] = p; }
            __syncthreads();
            if (tid < 64) { float s = 0.f;
#pragma unroll
                for (int w = 0; w < 8; ++w) s += sRS[w * 64 + tid];
                sR[tid] = rsqrtf(s * (1.0f / 256.0f) + EPS_); }
            __syncthreads();
#pragma unroll
            for (int tt = 0; tt < 4; ++tt)
#pragma unroll
                for (int j = 0; j < 4; ++j) { const int t = 16 * tt + fq * 4 + j; const float rs = sR[t];
#pragma unroll
                    for (int v2 = 0; v2 < 2; ++v2) { const int vc = 16 * (2 * wave + v2) + fr;
                        const float og = bf2f(PROJ[(size_t)(m0 + t) * NPROJ + C_OG + h * 256 + vc]);
                        const float val = o[tt][v2][j] * rs * P.head_gain[vc] * og * sigmoidf_(og);
                        AB[(size_t)(m0 + t) * 2048 + 1024 + h * 256 + vc] = (bf16_t)(pk2(val, 0.f) & 0xffffu); } }
            __syncthreads();
        }
    }
    grid.sync();

    {
        pg8::StaticOrder S; S.init(M_, 2048, G, bid);
        { pg8::Gemm g{Hb, WT_ao, 2048, 1024, M_, 2048, 1024}; Epi<EP_GATE> E{nullptr, 0, PROJ + C_GA, NPROJ, TMP, nullptr}; pg8::gemm_phase(lds, g, S, E); }
        { pg8::Gemm g{Hb + 1024, WT_bo, 2048, 1024, M_, 2048, 1024}; Epi<EP_GATEADD> E{MIX, 2048, PROJ + C_GB, NPROJ, TMP, nullptr}; pg8::gemm_phase(lds, g, S, E); }
    }
    grid.sync();

    {
        pg8::Gemm g{MIX, WT_mix, 2048, 2048, M_, 2048, 2048}; pg8::StaticOrder S; S.init(M_, 2048, G, bid);
        Epi<EP_F32PART> E{Tb, 2048, nullptr, 0, nullptr, PART};
        pg8::gemm_phase(lds, g, S, E);
    }
    grid.sync();

    for (int m = gw; m < M_; m += NGW) row_pass(Tb, PART, P.x, P.out, Hb, P.g_post_mix, P.g_pre_ffn, m, lane);
    grid.sync();

    {
        pg8::Gemm g{Hb, WT_ff1, 2048, 2048, M_, NFF1, 2048}; pg8::StaticOrder S; S.init(M_, NFF1, G, bid);
        Epi<EP_SWIGLU> E{GU, FF_, nullptr, 0, nullptr, nullptr};
        pg8::gemm_phase(lds, g, S, E);
    }
    grid.sync();

    {
        pg8::Gemm g{GU, WT_dn, FF_, FF_, M_, 2048, FF_}; pg8::StaticOrder S; S.init(M_, 2048, G, bid);
        Epi<EP_F32PART> E{Tb, 2048, nullptr, 0, nullptr, PART};
        pg8::gemm_phase(lds, g, S, E);
    }
    grid.sync();

    for (int m = gw; m < M_; m += NGW) row_pass(Tb, PART, P.out, P.out, Hb, P.g_post_ffn, P.g_pre_ple, m, lane);
    grid.sync();

    {
        pg8::StaticOrder S; S.init(M_, 2048, G, bid);
        { pg8::Gemm g{PBF, WT_pp, 256, 256, M_, 2048, 256}; Epi<EP_F32> E{TMP2, 2048, nullptr, 0, nullptr, nullptr}; pg8::gemm_phase(lds, g, S, E); }
        { pg8::Gemm g{Hb, WT_pg, 2048, 2048, M_, 2048, 2048}; Epi<EP_SIGMUL> E{Tb, 2048, TMP2, 2048, nullptr, PART}; pg8::gemm_phase(lds, g, S, E); }
    }
    grid.sync();

    for (int m = gw; m < M_; m += NGW) row_pass(Tb, PART, P.out, P.out, nullptr, P.g_post_ple, nullptr, m, lane);
}

extern "C" void kernel_launch(void* const* d_in, const int* in_sizes, int n_in, void* d_out, int out_size, void* d_ws, size_t ws_size, hipStream_t stream) {
    static int grid_blocks = 0;
    if (grid_blocks == 0) {
        if (n_in != 21 || out_size != M_ * D_ || ws_size < WS_END) { fprintf(stderr, "kernel_launch: unexpected shapes (n_in %d, out %d, ws %zu, need %zu)\n", n_in, out_size, ws_size, (size_t)WS_END); grid_blocks = -1; return; }
        int dev = 0, cus = 0, per_cu = 0;
        (void)hipGetDevice(&dev);
        (void)hipDeviceGetAttribute(&cus, hipDeviceAttributeMultiprocessorCount, dev);
        if (hipFuncSetAttribute((const void*)mega_fwd, hipFuncAttributeMaxDynamicSharedMemorySize, LDS_BYTES) != hipSuccess) { fprintf(stderr, "kernel_launch: hipFuncSetAttribute failed\n"); grid_blocks = -1; return; }
        if (hipOccupancyMaxActiveBlocksPerMultiprocessor(&per_cu, (const void*)mega_fwd, 512, LDS_BYTES) != hipSuccess || per_cu < 1) { fprintf(stderr, "kernel_launch: occupancy query says %d\n", per_cu); grid_blocks = -1; return; }
        grid_blocks = cus;
    }
    if (grid_blocks < 0) return;
    Params p{};
    const float** pp = (const float**)&p;
    for (int i = 0; i < 21; ++i) pp[i] = (const float*)d_in[i];
    p.out = (float*)d_out; p.ws = (unsigned char*)d_ws;
    void* args[] = {&p};
    hipError_t e = hipLaunchCooperativeKernel((const void*)mega_fwd, dim3(grid_blocks), dim3(512), args, LDS_BYTES, stream);
    if (e != hipSuccess) fprintf(stderr, "cooperative launch failed: %s (grid %d)\n", hipGetErrorString(e), grid_blocks);
}
```

```cpp
#include <hip/hip_runtime.h>
#include <hip/hip_cooperative_groups.h>
#include <cstdio>
namespace cg = cooperative_groups;

#define LAS __attribute__((address_space(3)))
typedef unsigned short bf16_t;
typedef short bf16x8 __attribute__((ext_vector_type(8)));
typedef float f32x4 __attribute__((ext_vector_type(4)));
typedef unsigned u32x4 __attribute__((ext_vector_type(4)));
typedef unsigned u32x2 __attribute__((ext_vector_type(2)));

constexpr int M_ = 8192, D_ = 2048, SEQ_ = 2048, NPROJ = 10240, FF_ = 5632, NFF1 = 11264, WIN_LD = 10256;
constexpr int C_AX = 0, C_AB = 1024, C_AC = 2048, C_Q = 3072, C_K = 3584, C_V = 4096, C_OG = 5120, C_GA = 6144, C_GB = 8192;
constexpr float EPS_ = 1e-6f;
constexpr int LDS_BYTES = 131072 + 256;

constexpr size_t WS_WIN = 0;
constexpr size_t WS_WAO = WS_WIN + (size_t)NPROJ * 2048 * 2;
constexpr size_t WS_WBO = WS_WAO + (size_t)2048 * 1024 * 2;
constexpr size_t WS_WMIX = WS_WBO + (size_t)2048 * 1024 * 2;
constexpr size_t WS_WFF1 = WS_WMIX + (size_t)2048 * 2048 * 2;
constexpr size_t WS_WDN = WS_WFF1 + (size_t)NFF1 * 2048 * 2;
constexpr size_t WS_WPG = WS_WDN + (size_t)2048 * FF_ * 2;
constexpr size_t WS_WPP = WS_WPG + (size_t)2048 * 2048 * 2;
constexpr size_t WS_H = WS_WPP + (size_t)2048 * 256 * 2;
constexpr size_t WS_PROJ = WS_H + (size_t)M_ * 2048 * 2;
constexpr size_t WS_ALR = WS_PROJ + (size_t)M_ * NPROJ * 2;
constexpr size_t WS_DEC = WS_ALR + (size_t)M_ * 16 * 4;
constexpr size_t WS_PART = WS_DEC + (size_t)512 * 128 * 4;
constexpr size_t WS_PBF = WS_PART + (size_t)M_ * 32 * 4;
constexpr size_t WS_BAR = WS_PBF + (size_t)M_ * 256 * 2;
constexpr size_t WS_BAR_BYTES = 16384;
constexpr size_t WS_END = WS_BAR + WS_BAR_BYTES;
constexpr size_t WS_T = WS_PROJ;
constexpr size_t WS_GU = WS_PROJ + (size_t)64 * 1024 * 1024;

__device__ __forceinline__ unsigned pk2(float lo, float hi) { unsigned r; asm("v_cvt_pk_bf16_f32 %0, %1, %2" : "=v"(r) : "v"(lo), "v"(hi)); return r; }
__device__ __forceinline__ float bflo(unsigned w) { return __uint_as_float(w << 16); }
__device__ __forceinline__ float bfhi(unsigned w) { return __uint_as_float(w & 0xffff0000u); }
__device__ __forceinline__ float bf2f(bf16_t b) { return __uint_as_float(((unsigned)b) << 16); }
__device__ __forceinline__ float sigmoidf_(float x) { return __builtin_amdgcn_rcpf(1.0f + __expf(-x)); }
__device__ __forceinline__ float wave_sum(float v) {
#pragma unroll
    for (int o = 1; o < 64; o <<= 1) v += __shfl_xor(v, o);
    return v;
}
__device__ __forceinline__ float dot4(f32x4 a, f32x4 b) { return (a.x * b.x + a.y * b.y) + (a.z * b.z + a.w * b.w); }
__device__ __forceinline__ void unpack8(u32x4 w, float (&f)[8]) {
    f[0] = bflo(w.x); f[1] = bfhi(w.x); f[2] = bflo(w.y); f[3] = bfhi(w.y); f[4] = bflo(w.z); f[5] = bfhi(w.z); f[6] = bflo(w.w); f[7] = bfhi(w.w);
}
__device__ __forceinline__ bf16x8 pack8(const float (&f)[8]) {
    u32x4 w; w.x = pk2(f[0], f[1]); w.y = pk2(f[2], f[3]); w.z = pk2(f[4], f[5]); w.w = pk2(f[6], f[7]);
    return __builtin_bit_cast(bf16x8, w);
}
#define LDS_WAIT() asm volatile("s_waitcnt lgkmcnt(0)" ::: "memory")


#define XB_TMO      128
#define XB_XCNT(j)  (256  + 64 * (j))
#define XB_XSUB(j)  (1280 + 64 * (j))
#define XB_XGEN(j)  (2304 + 64 * (j))
#define XB_TOP      3328
#define XB_TOPGEN   3392
#define XCD_BAR_WORDS 3456
#define XB_SPIN_CAP (1u << 18)
__device__ __forceinline__ unsigned xb_ld(unsigned* p)              { return __hip_atomic_load(p, __ATOMIC_RELAXED, __HIP_MEMORY_SCOPE_AGENT); }
__device__ __forceinline__ unsigned xb_add(unsigned* p, unsigned v) { return __hip_atomic_fetch_add(p, v, __ATOMIC_RELAXED, __HIP_MEMORY_SCOPE_AGENT); }
__device__ __forceinline__ unsigned xb_xcc_id() { return (unsigned)__builtin_amdgcn_s_getreg((3 << 11) | 20) & 0xFu; }
#define XB_SPIN(cond, bar) do { unsigned _sp = 0; while (cond) { __builtin_amdgcn_s_sleep(1); \
    if ((++_sp & 255u) == 0u) { if (xb_ld(&(bar)[XB_TMO])) break; if (_sp > XB_SPIN_CAP) { atomicAdd(&(bar)[XB_TMO], 1u); break; } } } } while (0)
struct XcdBarrier { unsigned* bar; unsigned x; volatile LAS unsigned* st; };
__device__ __forceinline__ XcdBarrier xcd_barrier_post(unsigned* bar, volatile LAS unsigned* st) {
    XcdBarrier b; b.bar = bar; b.x = xb_xcc_id(); b.st = st;
    if (threadIdx.x == 0) (void)xb_add(&bar[XB_XCNT(b.x)], 1u);
    return b;
}
__device__ __forceinline__ void xcd_barrier_complete(unsigned* bar, unsigned x, unsigned& nloc, unsigned& nx) {
    const unsigned G = gridDim.x * gridDim.y * gridDim.z;
    unsigned sum, cnt, mine, sp = 0u;
    for (;;) {
        sum = 0u; cnt = 0u; mine = 0u;
#pragma unroll
        for (unsigned j = 0; j < 16; ++j) { const unsigned c = xb_ld(&bar[XB_XCNT(j)]); sum += c; cnt += (c > 0u) ? 1u : 0u; mine = (j == x) ? c : mine; }
        if (sum == G) break;
        __builtin_amdgcn_s_sleep(1);
        if ((++sp & 255u) == 0u) { if (xb_ld(&bar[XB_TMO])) break; if (sp > XB_SPIN_CAP) { atomicAdd(&bar[XB_TMO], 1u); break; } }
    }
    nloc = mine > 0u ? mine : 1u; nx = cnt > 0u ? cnt : 1u;
}
__device__ __forceinline__ void xcd_barrier(const XcdBarrier& b) {
    asm volatile("s_waitcnt vmcnt(0)" ::: "memory");
    __syncthreads();
    if (threadIdx.x == 0) {
        unsigned* bar = b.bar;
        __builtin_amdgcn_s_waitcnt(0);
        unsigned nloc = b.st[0], nx = b.st[1];
        if (nloc == 0u) { xcd_barrier_complete(bar, b.x, nloc, nx); b.st[0] = nloc; b.st[1] = nx; }
        const unsigned old = xb_add(&bar[XB_XSUB(b.x)], 1u);
        const unsigned gen = old / nloc;
        if (old + 1u == (gen + 1u) * nloc) {
            __builtin_amdgcn_fence(__ATOMIC_RELEASE, "agent");
            asm volatile("s_waitcnt vmcnt(0)" ::: "memory");
            const unsigned og = xb_add(&bar[XB_TOP], 1u);
            const unsigned tg = og / nx;
            if (og + 1u == (tg + 1u) * nx) xb_add(&bar[XB_TOPGEN], 1u);
            else XB_SPIN(xb_ld(&bar[XB_TOPGEN]) == tg, bar);
            __builtin_amdgcn_fence(__ATOMIC_ACQUIRE, "agent");
            xb_add(&bar[XB_XGEN(b.x)], 1u);
            asm volatile("s_waitcnt vmcnt(0)" ::: "memory");
        } else {
            XB_SPIN(xb_ld(&bar[XB_XGEN(b.x)]) == gen, bar);
            __builtin_amdgcn_fence(__ATOMIC_ACQUIRE, "agent");
            asm volatile("s_waitcnt vmcnt(0)" ::: "memory");
        }
    }
    __syncthreads();
}

namespace pg8 {
constexpr int BM = 256, BK = 64, HALF = 128, HTB = HALF * BK * 2, NXCD = 8, WGM = 8;
__device__ __forceinline__ int lds_byte(int r, int c) { const int st = (r >> 4) * 2 + (c >> 5), rr = r & 15, cc = c & 31, ob = rr * 64 + cc * 2; return st * 1024 + (ob ^ (((ob >> 9) & 1) << 5)); }
__device__ __forceinline__ void stage_rc(int b, int& R, int& C) { const int st = b / 1024, sb = b % 1024, swz = sb ^ (((sb >> 9) & 1) << 5); R = (st >> 1) * 16 + swz / 64; C = (st & 1) * 32 + (swz % 64) / 2; }
__device__ __forceinline__ int perm32(int rho) { const int n = rho >> 4, i = rho & 15; return 8 * (i >> 2) + 4 * n + (i & 3); }

struct Unit { int pm, pn; };
struct Gemm { const bf16_t* A; const bf16_t* Bt; int lda, ldb, M, N, K; };

struct StaticOrder {
    int nM, nN, nwg, G, c;
    __device__ void init(int M, int N, int G_, int c_) { nM = M / BM; nN = N / BM; nwg = nM * nN; G = G_; c = c_; }
    __device__ bool next(int i, Unit& u) const {
        const long L = (long)i * G + c; if (L >= nwg) return false;
        int wgid = (int)L; { const int q = nwg / NXCD, r = nwg % NXCD, xcd = wgid % NXCD, off = wgid / NXCD; wgid = (xcd < r ? xcd * (q + 1) : r * (q + 1) + (xcd - r) * q) + off; }
        const int nig = WGM * nN, gid = wgid / nig, fm = gid * WGM, gsz = (nM - fm) < WGM ? (nM - fm) : WGM;
        u.pm = fm + ((wgid % nig) % gsz); u.pn = (wgid % nig) / gsz; return true;
    }
};

template <class Epi>
__device__ __forceinline__ void gemm_phase(LAS unsigned char* lds, const Gemm g, const StaticOrder& S, const Epi& E) {
    const int tid = threadIdx.x, wid = __builtin_amdgcn_readfirstlane(tid >> 6), lane = tid & 63, wr = wid >> 2, wc = wid & 3, fr = lane & 15, fq = lane >> 4;
    const int K = g.K, nt = K / BK;
    unsigned voffA[2], voffB[2];
#pragma unroll
    for (int i = 0; i < 2; ++i) { int R, C; stage_rc(tid * 16 + i * 8192, R, C); const int Rb = Epi::PERM ? ((R & ~31) + perm32(R & 31)) : R;
        voffA[i] = (unsigned)(R * g.lda + C) * 2u; voffB[i] = (unsigned)(Rb * g.ldb + C) * 2u; }
    const size_t kstep = (size_t)(BK * 2);
    const size_t hstepA = (size_t)HALF * g.lda * 2, hstepB = (size_t)HALF * g.ldb * 2;
    const size_t tstepA = 2 * hstepA, tstepB = 2 * hstepB;
    const unsigned ldsw = (unsigned)wid * 1024u;
    const int aoff = lds_byte(wr * 64 + fr, fq * 8), boff = lds_byte(wc * 32 + fr, fq * 8);
#define PG8_SA(b, h) (((b) * 2 + (h)) * HTB)
#define PG8_SB(b, h) ((4 + (b) * 2 + (h)) * HTB)
#define PG8_STAGE(bufoff, gbase, voff) do { _Pragma("unroll") for (int _i = 0; _i < 2; ++_i) \
        __builtin_amdgcn_global_load_lds((const unsigned*)((const char*)(gbase) + (voff)[_i]), (LAS unsigned*)(lds + (bufoff) + ldsw + _i * 8192), 16, 0, 0); } while (0)
#define PG8_LDA(dst, b, h) do { _Pragma("unroll") for (int m = 0; m < 4; ++m) _Pragma("unroll") for (int k = 0; k < 2; ++k) dst[m][k] = *(const LAS bf16x8*)(lds + PG8_SA(b, h) + aoff + m * 2048 + k * 1024); } while (0)
#define PG8_LDB(dst, b, h) do { _Pragma("unroll") for (int n = 0; n < 2; ++n) _Pragma("unroll") for (int k = 0; k < 2; ++k) dst[n][k] = *(const LAS bf16x8*)(lds + PG8_SB(b, h) + boff + n * 2048 + k * 1024); } while (0)
#define PG8_MMA(ai, bj, At, Bt) do { __builtin_amdgcn_s_setprio(1); _Pragma("unroll") for (int m = 0; m < 4; ++m) _Pragma("unroll") for (int n = 0; n < 2; ++n) _Pragma("unroll") for (int k = 0; k < 2; ++k) \
        acc[ai][bj][m][n] = __builtin_amdgcn_mfma_f32_16x16x32_bf16(Bt[n][k], At[m][k], acc[ai][bj][m][n], 0, 0, 0); __builtin_amdgcn_s_setprio(0); } while (0)
#define PG8_WAIT_V(n) asm volatile("s_waitcnt vmcnt(" #n ")" ::: "memory")
#define PG8_WAIT_L(n) asm volatile("s_waitcnt lgkmcnt(" #n ")" ::: "memory")
#define PG8_BAR __builtin_amdgcn_s_barrier()
#define PG8_SCHED __builtin_amdgcn_sched_barrier(0)
    Unit cur, nxt; int ui = 0;
    if (!S.next(0, cur)) return;
    f32x4 acc[2][2][4][2];
#pragma unroll
    for (int a = 0; a < 2; ++a)
#pragma unroll
        for (int b = 0; b < 2; ++b)
#pragma unroll
            for (int m = 0; m < 4; ++m)
#pragma unroll
                for (int n = 0; n < 2; ++n) acc[a][b][m][n] = (f32x4){0.f, 0.f, 0.f, 0.f};
    bf16x8 At[4][2], B0[2][2], B1[2][2];
    const char* cA = (const char*)g.A + (size_t)cur.pm * tstepA; const char* cB = (const char*)g.Bt + (size_t)cur.pn * tstepB;
    PG8_STAGE(PG8_SB(0, 0), cB, voffB); PG8_STAGE(PG8_SA(0, 0), cA, voffA); PG8_STAGE(PG8_SB(0, 1), cB + hstepB, voffB); PG8_STAGE(PG8_SA(0, 1), cA + hstepA, voffA);
    if (wr == 1) PG8_BAR;
    PG8_WAIT_V(4); PG8_BAR;
    PG8_STAGE(PG8_SB(1, 0), cB + kstep, voffB); PG8_STAGE(PG8_SA(1, 0), cA + kstep, voffA); PG8_STAGE(PG8_SB(1, 1), cB + hstepB + kstep, voffB);
    PG8_WAIT_V(6); PG8_BAR;
    for (;;) {
        const bool has_next = S.next(ui + 1, nxt);
        const char* nA = has_next ? (const char*)g.A + (size_t)nxt.pm * tstepA : cA; const char* nB = has_next ? (const char*)g.Bt + (size_t)nxt.pn * tstepB : cB;
        for (int t = 0; t < nt; t += 2) {
            const bool last = (t == nt - 2);
            const char* a1 = cA + (size_t)(t + 1) * kstep;
            const char* a2 = last ? nA : cA + (size_t)(t + 2) * kstep; const char* b2 = last ? nB : cB + (size_t)(t + 2) * kstep;
            const char* a3 = a2 + kstep; const char* b3 = b2 + kstep;
            PG8_LDB(B0, 0, 0); PG8_SCHED; PG8_LDA(At, 0, 0); PG8_STAGE(PG8_SA(1, 1), a1 + hstepA, voffA);
            PG8_WAIT_L(8); PG8_BAR; PG8_WAIT_L(0); PG8_MMA(0, 0, At, B0); PG8_BAR; PG8_SCHED;
            PG8_LDB(B1, 0, 1); PG8_STAGE(PG8_SB(0, 0), b2, voffB);
            PG8_BAR; PG8_WAIT_L(0); PG8_MMA(0, 1, At, B1); PG8_BAR;
            PG8_LDA(At, 0, 1); PG8_STAGE(PG8_SA(0, 0), a2, voffA);
            PG8_BAR; PG8_WAIT_L(0); PG8_MMA(1, 0, At, B0); PG8_BAR; PG8_SCHED;
            PG8_STAGE(PG8_SB(0, 1), b2 + hstepB, voffB);
            PG8_WAIT_V(6); PG8_BAR; PG8_MMA(1, 1, At, B1); PG8_BAR;
            PG8_LDB(B0, 1, 0); PG8_SCHED; PG8_LDA(At, 1, 0); PG8_STAGE(PG8_SA(0, 1), a2 + hstepA, voffA);
            PG8_WAIT_L(8); PG8_BAR; PG8_WAIT_L(0); PG8_MMA(0, 0, At, B0); PG8_BAR; PG8_SCHED;
            PG8_LDB(B1, 1, 1); PG8_STAGE(PG8_SB(1, 0), b3, voffB);
            PG8_BAR; PG8_WAIT_L(0); PG8_MMA(0, 1, At, B1); PG8_BAR;
            PG8_LDA(At, 1, 1); PG8_STAGE(PG8_SA(1, 0), a3, voffA);
            PG8_BAR; PG8_WAIT_L(0); PG8_MMA(1, 0, At, B0); PG8_BAR; PG8_SCHED;
            PG8_STAGE(PG8_SB(1, 1), b3 + hstepB, voffB);
            PG8_WAIT_V(6); PG8_BAR; PG8_MMA(1, 1, At, B1); PG8_BAR;
        }
        E(acc, cur.pm, cur.pn, wr, wc, fr, fq);
        if (!has_next) break;
#pragma unroll
        for (int a = 0; a < 2; ++a)
#pragma unroll
            for (int b = 0; b < 2; ++b)
#pragma unroll
                for (int m = 0; m < 4; ++m)
#pragma unroll
                    for (int n = 0; n < 2; ++n) acc[a][b][m][n] = (f32x4){0.f, 0.f, 0.f, 0.f};
        cur = nxt; cA = nA; cB = nB; ++ui;
    }
    PG8_WAIT_V(0);
    if (wr == 0) PG8_BAR;
    PG8_BAR;
#undef PG8_SA
#undef PG8_SB
#undef PG8_STAGE
#undef PG8_LDA
#undef PG8_LDB
#undef PG8_MMA
#undef PG8_WAIT_V
#undef PG8_WAIT_L
#undef PG8_BAR
#undef PG8_SCHED
}
}

enum { EP_BF16 = 0, EP_GATE = 1, EP_GATEADD = 2, EP_F32PART = 3, EP_SWIGLU = 4, EP_F32 = 5, EP_SIGMUL = 6 };
template <int MODE> struct Epi {
    static constexpr bool PERM = (MODE == EP_BF16 || MODE == EP_GATE || MODE == EP_GATEADD || MODE == EP_SWIGLU);
    void* out; int ldo;
    const void* aux; int ldaux;
    float* tmp;
    float* part;
    __device__ __forceinline__ void operator()(const f32x4 (&acc)[2][2][4][2], int pm, int pn, int wr, int wc, int fr, int fq) const {
        const int row0 = pm * 256 + wr * 64 + fr;
        const int cl = 32 * wc + (PERM ? 8 * fq : 4 * fq);
#pragma unroll
        for (int ai = 0; ai < 2; ++ai)
#pragma unroll
        for (int m = 0; m < 4; ++m) {
            const size_t r = (size_t)(row0 + ai * 128 + m * 16);
            if constexpr (MODE == EP_SWIGLU) {
                u32x4 w; unsigned ww[4];
#pragma unroll
                for (int n = 0; n < 2; ++n) { const f32x4 g = acc[ai][0][m][n], u = acc[ai][1][m][n]; float v[4];
#pragma unroll
                    for (int j = 0; j < 4; ++j) v[j] = g[j] * sigmoidf_(g[j]) * u[j];
                    ww[2 * n] = pk2(v[0], v[1]); ww[2 * n + 1] = pk2(v[2], v[3]); }
                w.x = ww[0]; w.y = ww[1]; w.z = ww[2]; w.w = ww[3];
                *(u32x4*)((bf16_t*)out + r * ldo + pn * 128 + cl) = w;
            } else {
                float ss = 0.f;
#pragma unroll
                for (int bj = 0; bj < 2; ++bj) {
                    const int c = pn * 256 + bj * 128 + cl;
                    if constexpr (MODE == EP_BF16) {
                        const f32x4 a0 = acc[ai][bj][m][0], a1 = acc[ai][bj][m][1]; u32x4 w;
                        w.x = pk2(a0[0], a0[1]); w.y = pk2(a0[2], a0[3]); w.z = pk2(a1[0], a1[1]); w.w = pk2(a1[2], a1[3]);
                        *(u32x4*)((bf16_t*)out + r * ldo + c) = w;
                    } else if constexpr (MODE == EP_GATE || MODE == EP_GATEADD) {
                        const u32x4 gw = *(const u32x4*)((const bf16_t*)aux + r * ldaux + c); float gt[8]; unpack8(gw, gt);
                        f32x4 v0, v1; const f32x4 a0 = acc[ai][bj][m][0], a1 = acc[ai][bj][m][1];
#pragma unroll
                        for (int j = 0; j < 4; ++j) { v0[j] = a0[j] * sigmoidf_(gt[j]); v1[j] = a1[j] * sigmoidf_(gt[4 + j]); }
                        float* tp = tmp + r * 2048 + c;
                        if constexpr (MODE == EP_GATE) { *(f32x4*)tp = v0; *(f32x4*)(tp + 4) = v1; }
                        else { const f32x4 t0 = *(const f32x4*)tp, t1 = *(const f32x4*)(tp + 4); v0 += t0; v1 += t1; u32x4 w;
                            w.x = pk2(v0[0], v0[1]); w.y = pk2(v0[2], v0[3]); w.z = pk2(v1[0], v1[1]); w.w = pk2(v1[2], v1[3]);
                            *(u32x4*)((bf16_t*)out + r * ldo + c) = w; }
                    } else {
#pragma unroll
                        for (int n = 0; n < 2; ++n) { f32x4 a = acc[ai][bj][m][n]; float* op = (float*)out + r * ldo + c + 16 * n;
                            if constexpr (MODE == EP_SIGMUL) { const f32x4 t = *(const f32x4*)((const float*)aux + r * ldaux + c + 16 * n);
#pragma unroll
                                for (int j = 0; j < 4; ++j) a[j] = sigmoidf_(a[j]) * t[j]; }
                            *(f32x4*)op = a;
                            if constexpr (MODE != EP_F32) ss += dot4(a, a); }
                    }
                }
                if constexpr (MODE == EP_F32PART || MODE == EP_SIGMUL) {
                    ss += __shfl_xor(ss, 16); ss += __shfl_xor(ss, 32);
                    if (fq == 0) part[r * 32 + pn * 4 + wc] = ss;
                }
            }
        }
    }
};

struct Params {
    const float *x, *p, *w_in, *conv_w, *w_a_out, *w_alpha_up, *b_alpha_up, *head_gain, *w_b_out, *w_mix_out,
                *g_pre_mix, *g_post_mix, *g_pre_ffn, *g_post_ffn, *w_ff_gate, *w_ff_up, *w_ff_down, *g_pre_ple, *g_post_ple, *w_ple_gate, *w_ple_proj;
    float* out; unsigned char* ws;
};

__device__ __forceinline__ void tr_item(const float* src, int ld_src, bf16_t* dst, int ldd, LAS float* scr, int lane) {
#pragma unroll 8
    for (int i = 0; i < 32; ++i) { const int kk = 2 * i + (lane >> 5); scr[kk * 33 + (lane & 31)] = src[(size_t)kk * ld_src + (lane & 31)]; }
    LDS_WAIT();
    const int c = lane & 7;
#pragma unroll
    for (int j = 0; j < 4; ++j) { const int n = (lane >> 3) + 8 * j; const LAS float* s = scr + (8 * c) * 33 + n;
        u32x4 o; o.x = pk2(s[0 * 33], s[1 * 33]); o.y = pk2(s[2 * 33], s[3 * 33]); o.z = pk2(s[4 * 33], s[5 * 33]); o.w = pk2(s[6 * 33], s[7 * 33]);
        *(u32x4*)(dst + (size_t)n * ldd + 8 * c) = o; }
    LDS_WAIT();
}

__device__ __forceinline__ void row_pass(const float* T, const float* part, const float* xin, float* xout, bf16_t* H, const float* gpost, const float* gpre, int m, int lane) {
    f32x4 v[8];
    const f32x4* xr = (const f32x4*)(xin + (size_t)m * D_) + lane;
    if (T) {
        float ps = lane < 32 ? part[(size_t)m * 32 + lane] : 0.f;
        const float rs = rsqrtf(wave_sum(ps) * (1.0f / D_) + EPS_);
        const f32x4* tr = (const f32x4*)(T + (size_t)m * D_) + lane; const f32x4* gp = (const f32x4*)gpost + lane;
#pragma unroll
        for (int j = 0; j < 8; ++j) { const f32x4 t = tr[64 * j], xv = xr[64 * j], g = gp[64 * j]; v[j] = xv + t * rs * g; }
    } else {
#pragma unroll
        for (int j = 0; j < 8; ++j) v[j] = xr[64 * j];
    }
    if (xout) { f32x4* xo = (f32x4*)(xout + (size_t)m * D_) + lane;
#pragma unroll
        for (int j = 0; j < 8; ++j) xo[64 * j] = v[j]; }
    if (H) {
        float s = 0.f;
#pragma unroll
        for (int j = 0; j < 8; ++j) s += dot4(v[j], v[j]);
        const float rs = rsqrtf(wave_sum(s) * (1.0f / D_) + EPS_);
        const f32x4* gq = (const f32x4*)gpre + lane; u32x2* ho = (u32x2*)(H + (size_t)m * D_) + lane;
#pragma unroll
        for (int j = 0; j < 8; ++j) { const f32x4 g = gq[64 * j]; const f32x4 h = v[j] * rs * g; u32x2 w; w.x = pk2(h[0], h[1]); w.y = pk2(h[2], h[3]); ho[64 * j] = w; }
    }
}

constexpr int GL_A = 0;
constexpr int GL_B = 4096;
constexpr int GL_V = GL_B + 64 * 132 * 4;
constexpr int GL_K = GL_V + 64 * 264 * 2;
constexpr int GL_RS = GL_K + 64 * 136 * 2;
static_assert(GL_RS + 2048 + 256 <= LDS_BYTES, "GLA LDS");

__device__ __forceinline__ void gla_bc(const float* ALR, const float* w_up, const float* b_up, int m0, int h, LAS float* sA, LAS float* sB, int tid) {
    if (tid < 256) { const f32x4 v = *(const f32x4*)(ALR + (size_t)m0 * 16 + tid * 4); *(LAS f32x4*)(sA + tid * 4) = v; }
    __syncthreads();
    const int d = tid & 127, seg = tid >> 7;
    float w[16];
#pragma unroll
    for (int r = 0; r < 16; ++r) w[r] = w_up[r * 512 + h * 128 + d];
    const float bias = b_up[h * 128 + d];
    float run = 0.f;
#pragma unroll 4
    for (int i = 0; i < 16; ++i) { const int t = seg * 16 + i; float z = bias;
#pragma unroll
        for (int r4 = 0; r4 < 4; ++r4) { const f32x4 a = *(const LAS f32x4*)(sA + t * 16 + r4 * 4); z += a.x * w[4 * r4] + a.y * w[4 * r4 + 1] + a.z * w[4 * r4 + 2] + a.w * w[4 * r4 + 3]; }
        const float ls = fminf(z, 0.f) - __logf(1.0f + __expf(-fabsf(z)));
        run += ls * (1.0f / 16.0f); sB[t * 132 + d] = run; }
    __syncthreads();
    float off = 0.f;
    for (int s = 0; s < seg; ++s) off += sB[(16 * s + 15) * 132 + d];
    __syncthreads();
    if (seg > 0) {
#pragma unroll 4
        for (int i = 0; i < 16; ++i) sB[(seg * 16 + i) * 132 + d] += off; }
    __syncthreads();
}

__global__ void __launch_bounds__(512, 2) mega_fwd(Params P) {
    extern __shared__ __attribute__((aligned(16))) unsigned char lds_raw[];
    LAS unsigned char* lds = (LAS unsigned char*)lds_raw;
    cg::grid_group grid = cg::this_grid();
    const int tid = threadIdx.x, lane = tid & 63, wave = __builtin_amdgcn_readfirstlane(tid >> 6);
    const int G = gridDim.x, bid = blockIdx.x;
    const int gw = bid * 8 + wave, NGW = G * 8;
    const int gtid = bid * 512 + tid, NT = G * 512;
    unsigned char* ws = P.ws;
    volatile LAS unsigned* xst = (volatile LAS unsigned*)(lds + 131072);
    if (tid < 2) xst[tid] = 0u;
    __syncthreads();
    const XcdBarrier xbar = xcd_barrier_post((unsigned*)(ws + WS_BAR), xst);
    bf16_t* WT_in = (bf16_t*)(ws + WS_WIN); bf16_t* WT_ao = (bf16_t*)(ws + WS_WAO); bf16_t* WT_bo = (bf16_t*)(ws + WS_WBO); bf16_t* WT_mix = (bf16_t*)(ws + WS_WMIX);
    bf16_t* WT_ff1 = (bf16_t*)(ws + WS_WFF1); bf16_t* WT_dn = (bf16_t*)(ws + WS_WDN); bf16_t* WT_pg = (bf16_t*)(ws + WS_WPG); bf16_t* WT_pp = (bf16_t*)(ws + WS_WPP);
    bf16_t* Hb = (bf16_t*)(ws + WS_H); bf16_t* PROJ = (bf16_t*)(ws + WS_PROJ); float* ALR = (float*)(ws + WS_ALR); float* DEC = (float*)(ws + WS_DEC);
    float* PART = (float*)(ws + WS_PART); bf16_t* PBF = (bf16_t*)(ws + WS_PBF);
    bf16_t* MIX = (bf16_t*)(ws + WS_WIN); float* Tb = (float*)(ws + WS_T); bf16_t* GU = (bf16_t*)(ws + WS_GU); float* TMP2 = (float*)(ws + WS_GU);
    float* UT = P.out;
    float* TMP = P.out;

    {
        LAS float* scr = (LAS float*)(lds + wave * 8448);
        constexpr int I_IN = 32 * 320, I_AO = 16 * 64, I_MIX = 32 * 64, I_FF1 = 32 * 352, I_DN = 88 * 64, I_PG = 32 * 64, I_PP = 4 * 64;
        constexpr int NITEMS = I_IN + 2 * I_AO + I_MIX + I_FF1 + I_DN + I_PG + I_PP;
        for (int it = gw; it < NITEMS; it += NGW) {
            int r = it;
            if (r < I_IN) { const int kb = r / 320, nb = r % 320, n0 = 32 * nb, sc = n0 < 6144 ? n0 : n0 + 16;
                tr_item(P.w_in + (size_t)kb * 64 * WIN_LD + sc, WIN_LD, WT_in + (size_t)n0 * 2048 + kb * 64, 2048, scr, lane); continue; } r -= I_IN;
            if (r < I_AO) { const int kb = r / 64, nb = r % 64; tr_item(P.w_a_out + (size_t)kb * 64 * 2048 + 32 * nb, 2048, WT_ao + (size_t)32 * nb * 1024 + kb * 64, 1024, scr, lane); continue; } r -= I_AO;
            if (r < I_AO) { const int kb = r / 64, nb = r % 64; tr_item(P.w_b_out + (size_t)kb * 64 * 2048 + 32 * nb, 2048, WT_bo + (size_t)32 * nb * 1024 + kb * 64, 1024, scr, lane); continue; } r -= I_AO;
            if (r < I_MIX) { const int kb = r / 64, nb = r % 64; tr_item(P.w_mix_out + (size_t)kb * 64 * 2048 + 32 * nb, 2048, WT_mix + (size_t)32 * nb * 2048 + kb * 64, 2048, scr, lane); continue; } r -= I_MIX;
            if (r < I_FF1) { const int kb = r / 352, nb = r % 352, n0 = 32 * nb, pn = n0 >> 8, w = n0 & 255;
                const float* src = (w < 128 ? P.w_ff_gate : P.w_ff_up) + (size_t)kb * 64 * FF_ + 128 * pn + (w & 127);
                tr_item(src, FF_, WT_ff1 + (size_t)n0 * 2048 + kb * 64, 2048, scr, lane); continue; } r -= I_FF1;
            if (r < I_DN) { const int kb = r / 64, nb = r % 64; tr_item(P.w_ff_down + (size_t)kb * 64 * 2048 + 32 * nb, 2048, WT_dn + (size_t)32 * nb * FF_ + kb * 64, FF_, scr, lane); continue; } r -= I_DN;
            if (r < I_PG) { const int kb = r / 64, nb = r % 64; tr_item(P.w_ple_gate + (size_t)kb * 64 * 2048 + 32 * nb, 2048, WT_pg + (size_t)32 * nb * 2048 + kb * 64, 2048, scr, lane); continue; } r -= I_PG;
            { const int kb = r / 64, nb = r % 64; tr_item(P.w_ple_proj + (size_t)kb * 64 * 2048 + 32 * nb, 2048, WT_pp + (size_t)32 * nb * 256 + kb * 64, 256, scr, lane); }
        }
        for (int i = gtid; i < M_ * 256 / 8; i += NT) { const f32x4 a = *(const f32x4*)(P.p + (size_t)i * 8), b = *(const f32x4*)(P.p + (size_t)i * 8 + 4);
            u32x4 w; w.x = pk2(a[0], a[1]); w.y = pk2(a[2], a[3]); w.z = pk2(b[0], b[1]); w.w = pk2(b[2], b[3]); *(u32x4*)(PBF + (size_t)i * 8) = w; }
        __syncthreads();
        LAS float* sW = (LAS float*)lds;
        for (int i = 0; i < 16; ++i) { const int idx = tid + 512 * i, k = idx >> 2, r4 = idx & 3;
            const f32x4 v = *(const f32x4*)(P.w_in + (size_t)k * WIN_LD + 6144 + 4 * r4);
            sW[(4 * r4 + 0) * 2048 + k] = v.x; sW[(4 * r4 + 1) * 2048 + k] = v.y; sW[(4 * r4 + 2) * 2048 + k] = v.z; sW[(4 * r4 + 3) * 2048 + k] = v.w; }
        __syncthreads();
        for (int m = gw; m < M_; m += NGW) {
            const f32x4* xr = (const f32x4*)(P.x + (size_t)m * D_) + lane; const f32x4* gq = (const f32x4*)P.g_pre_mix + lane;
            f32x4 v[8]; float s = 0.f;
#pragma unroll
            for (int j = 0; j < 8; ++j) { v[j] = xr[64 * j]; s += dot4(v[j], v[j]); }
            const float rs = rsqrtf(wave_sum(s) * (1.0f / D_) + EPS_);
            u32x2* ho = (u32x2*)(Hb + (size_t)m * D_) + lane;
#pragma unroll
            for (int j = 0; j < 8; ++j) { const f32x4 g = gq[64 * j]; v[j] = v[j] * rs * g; u32x2 w; w.x = pk2(v[j][0], v[j][1]); w.y = pk2(v[j][2], v[j][3]); ho[64 * j] = w; }
            float mine = 0.f;
#pragma unroll
            for (int r = 0; r < 16; ++r) { float a = 0.f;
#pragma unroll
                for (int j = 0; j < 8; ++j) { const f32x4 wv = *(const LAS f32x4*)(sW + r * 2048 + 4 * lane + 256 * j); a += dot4(v[j], wv); }
                a = wave_sum(a); mine = (lane == r) ? a : mine; }
            if (lane < 16) ALR[(size_t)m * 16 + lane] = mine;
        }
    }
    grid.sync();

    {
        pg8::Gemm g{Hb, WT_in, 2048, 2048, M_, NPROJ, 2048}; pg8::StaticOrder S; S.init(M_, NPROJ, G, bid);
        Epi<EP_BF16> E{PROJ, NPROJ, nullptr, 0, nullptr, nullptr};
        pg8::gemm_phase(lds, g, S, E);
    }
    xcd_barrier(xbar);

    {
        bf16_t* AB = Hb;
        for (int idx = gtid; idx < M_ * 128; idx += NT) {
            const int m = idx >> 7, c = (idx & 127) * 8, t = m & (SEQ_ - 1);
            const bf16_t* pr = PROJ + (size_t)m * NPROJ;
            float u0[8], u1[8], u2[8], ab[8], tmpv[8];
            { u32x4 a = *(const u32x4*)(pr + C_AX + c), cc = *(const u32x4*)(pr + C_AC + c); unpack8(a, u0); unpack8(cc, tmpv);
#pragma unroll
              for (int i = 0; i < 8; ++i) u0[i] *= tmpv[i]; }
            if (t >= 1) { u32x4 a = *(const u32x4*)(pr - NPROJ + C_AX + c), cc = *(const u32x4*)(pr - NPROJ + C_AC + c); unpack8(a, u1); unpack8(cc, tmpv);
#pragma unroll
              for (int i = 0; i < 8; ++i) u1[i] *= tmpv[i]; }
            else {
#pragma unroll
              for (int i = 0; i < 8; ++i) u1[i] = 0.f; }
            if (t >= 2) { u32x4 a = *(const u32x4*)(pr - 2 * NPROJ + C_AX + c), cc = *(const u32x4*)(pr - 2 * NPROJ + C_AC + c); unpack8(a, u2); unpack8(cc, tmpv);
#pragma unroll
              for (int i = 0; i < 8; ++i) u2[i] *= tmpv[i]; }
            else {
#pragma unroll
              for (int i = 0; i < 8; ++i) u2[i] = 0.f; }
            { u32x4 b = *(const u32x4*)(pr + C_AB + c); unpack8(b, ab); }
            float y[8];
#pragma unroll
            for (int i4 = 0; i4 < 2; ++i4) { const f32x4 w0 = *(const f32x4*)(P.conv_w + c + 4 * i4), w1 = *(const f32x4*)(P.conv_w + 1024 + c + 4 * i4), w2 = *(const f32x4*)(P.conv_w + 2048 + c + 4 * i4);
#pragma unroll
                for (int j = 0; j < 4; ++j) { const int i = 4 * i4 + j; y[i] = ab[i] * (w0[j] * u2[i] + w1[j] * u1[i] + w2[j] * u0[i]); } }
            *(bf16x8*)(AB + (size_t)m * 2048 + c) = pack8(y);
        }
        LAS float* sA = (LAS float*)(lds + GL_A); LAS float* sB = (LAS float*)(lds + GL_B);
        LAS bf16_t* sV = (LAS bf16_t*)(lds + GL_V); LAS bf16_t* sK = (LAS bf16_t*)(lds + GL_K);
        const int fr = lane & 15, fq = lane >> 4;
        for (int item = bid; item < 512; item += G) {
            const int h = item & 3, bn = item >> 2, m0 = bn * 64;
            gla_bc(ALR, P.w_alpha_up, P.b_alpha_up, m0, h, sA, sB, tid);
#pragma unroll
            for (int it = 0; it < 2; ++it) { const int idx = tid + 512 * it, s = idx >> 4, g8 = (idx & 15) * 8;
                const u32x4 kw = *(const u32x4*)(PROJ + (size_t)(m0 + s) * NPROJ + C_K + h * 128 + g8); float kf[8]; unpack8(kw, kf);
#pragma unroll
                for (int i = 0; i < 8; ++i) kf[i] *= __expf(sB[63 * 132 + g8 + i] - sB[s * 132 + g8 + i]);
                *(LAS bf16x8*)(sK + s * 136 + g8) = pack8(kf); }
#pragma unroll
            for (int it = 0; it < 4; ++it) { const int idx = tid + 512 * it, s = idx >> 5, g8 = (idx & 31) * 8;
                *(LAS u32x4*)(sV + s * 264 + g8) = *(const u32x4*)(PROJ + (size_t)(m0 + s) * NPROJ + C_V + h * 256 + g8); }
            if (tid < 128) DEC[(size_t)item * 128 + tid] = __expf(sB[63 * 132 + tid]);
            __syncthreads();
            bf16x8 Bk[2];
#pragma unroll
            for (int ks = 0; ks < 2; ++ks) {
#pragma unroll
                for (int i = 0; i < 8; ++i) Bk[ks][i] = (short)sK[(ks * 32 + fq * 8 + i) * 136 + 16 * wave + fr]; }
            float* ut = UT + (size_t)item * 32768;
#pragma unroll 2
            for (int mt = 0; mt < 16; ++mt) {
                f32x4 acc = {0.f, 0.f, 0.f, 0.f};
#pragma unroll
                for (int ks = 0; ks < 2; ++ks) { bf16x8 Av;
#pragma unroll
                    for (int i = 0; i < 8; ++i) Av[i] = (short)sV[(ks * 32 + fq * 8 + i) * 264 + 16 * mt + fr];
                    acc = __builtin_amdgcn_mfma_f32_16x16x32_bf16(Av, Bk[ks], acc, 0, 0, 0); }
#pragma unroll
                for (int j = 0; j < 4; ++j) ut[(16 * mt + fq * 4 + j) * 128 + 16 * wave + fr] = acc[j];
            }
            __syncthreads();
        }
    }
    xcd_barrier(xbar);

    {
        for (int e = gtid; e < 16 * 32768; e += NT) {
            const int bh = e >> 15, rem = e & 32767, b = bh >> 2, h = bh & 3, d = rem & 127;
            float st = 0.f;
#pragma unroll 8
            for (int n = 0; n < 32; ++n) { const int item = (b * 32 + n) * 4 + h; float* p = UT + (size_t)item * 32768 + rem;
                const float u = *p, dec = DEC[item * 128 + d]; *p = st; st = dec * st + u; }
        }
    }
    xcd_barrier(xbar);

    {
        bf16_t* AB = Hb;
        LAS float* sA = (LAS float*)(lds + GL_A); LAS float* sB = (LAS float*)(lds + GL_B);
        LAS bf16_t* sV = (LAS bf16_t*)(lds + GL_V); LAS bf16_t* sT = (LAS bf16_t*)(lds + GL_K);
        LAS float* sRS = (LAS float*)(lds + GL_RS); LAS float* sR = (LAS float*)(lds + GL_RS + 2048);
        const int fr = lane & 15, fq = lane >> 4;
        const float scale = 0.08838834764831845f;
        for (int item = bid; item < 512; item += G) {
            const int h = item & 3, bn = item >> 2, m0 = bn * 64;
            gla_bc(ALR, P.w_alpha_up, P.b_alpha_up, m0, h, sA, sB, tid);
#pragma unroll
            for (int it = 0; it < 4; ++it) { const int idx = tid + 512 * it, s = idx >> 5, g8 = (idx & 31) * 8;
                *(LAS u32x4*)(sV + s * 264 + g8) = *(const u32x4*)(PROJ + (size_t)(m0 + s) * NPROJ + C_V + h * 256 + g8); }
            {
                const int tt = wave & 3, sp = wave >> 2;
                f32x4 af[2], ar[2];
#pragma unroll
                for (int i = 0; i < 2; ++i) { af[i] = (f32x4){0.f, 0.f, 0.f, 0.f}; ar[i] = (f32x4){0.f, 0.f, 0.f, 0.f}; }
#pragma unroll
                for (int kk = 0; kk < 4; ++kk) {
                    const int d0 = kk * 32 + fq * 8, t = 16 * tt + fr;
                    float mid[8], qf[8], qr[8];
                    { const f32x4 a = *(const LAS f32x4*)(sB + 32 * 132 + d0), b = *(const LAS f32x4*)(sB + 32 * 132 + d0 + 4);
                      mid[0] = a.x; mid[1] = a.y; mid[2] = a.z; mid[3] = a.w; mid[4] = b.x; mid[5] = b.y; mid[6] = b.z; mid[7] = b.w; }
                    { const u32x4 qw = *(const u32x4*)(PROJ + (size_t)(m0 + t) * NPROJ + C_Q + h * 128 + d0); float q[8]; unpack8(qw, q);
                      const f32x4 a = *(const LAS f32x4*)(sB + t * 132 + d0), b = *(const LAS f32x4*)(sB + t * 132 + d0 + 4);
                      const float bt[8] = {a.x, a.y, a.z, a.w, b.x, b.y, b.z, b.w};
#pragma unroll
                      for (int i = 0; i < 8; ++i) { const float qs = q[i] * scale; qf[i] = qs * __expf(bt[i] - mid[i]); qr[i] = qs * __expf(mid[i] - bt[i]); } }
                    const bf16x8 Af = pack8(qf), Ar = pack8(qr);
#pragma unroll
                    for (int s2 = 0; s2 < 2; ++s2) {
                        const int s = 16 * (2 * sp + s2) + fr; float kf[8], kr[8];
                        const u32x4 kw = *(const u32x4*)(PROJ + (size_t)(m0 + s) * NPROJ + C_K + h * 128 + d0); float k[8]; unpack8(kw, k);
                        const f32x4 a = *(const LAS f32x4*)(sB + s * 132 + d0), b = *(const LAS f32x4*)(sB + s * 132 + d0 + 4);
                        const float bs[8] = {a.x, a.y, a.z, a.w, b.x, b.y, b.z, b.w};
#pragma unroll
                        for (int i = 0; i < 8; ++i) { kf[i] = k[i] * __expf(mid[i] - bs[i]); kr[i] = k[i] * __expf(bs[i] - mid[i]); }
                        af[s2] = __builtin_amdgcn_mfma_f32_16x16x32_bf16(Af, pack8(kf), af[s2], 0, 0, 0);
                        ar[s2] = __builtin_amdgcn_mfma_f32_16x16x32_bf16(Ar, pack8(kr), ar[s2], 0, 0, 0);
                    }
                }
#pragma unroll
                for (int s2 = 0; s2 < 2; ++s2)
#pragma unroll
                    for (int j = 0; j < 4; ++j) { const int t = 16 * tt + fq * 4 + j, s = 16 * (2 * sp + s2) + fr;
                        const float v = (s <= t) ? af[s2][j] : ar[s2][j];
                        sT[t * 72 + s] = (bf16_t)(pk2(v, 0.f) & 0xffffu); }
            }
            __syncthreads();
            f32x4 o[4][2];
#pragma unroll
            for (int a = 0; a < 4; ++a)
#pragma unroll
                for (int b = 0; b < 2; ++b) o[a][b] = (f32x4){0.f, 0.f, 0.f, 0.f};
#pragma unroll
            for (int ks = 0; ks < 2; ++ks) {
                bf16x8 Bv[2];
#pragma unroll
                for (int v2 = 0; v2 < 2; ++v2)
#pragma unroll
                    for (int i = 0; i < 8; ++i) Bv[v2][i] = (short)sV[(ks * 32 + fq * 8 + i) * 264 + 16 * (2 * wave + v2) + fr];
#pragma unroll
                for (int tt = 0; tt < 4; ++tt) { const bf16x8 Aa = *(const LAS bf16x8*)(sT + (16 * tt + fr) * 72 + ks * 32 + fq * 8);
#pragma unroll
                    for (int v2 = 0; v2 < 2; ++v2) o[tt][v2] = __builtin_amdgcn_mfma_f32_16x16x32_bf16(Aa, Bv[v2], o[tt][v2], 0, 0, 0); }
            }
            const float* ut = UT + (size_t)item * 32768;
#pragma unroll
            for (int kk = 0; kk < 4; ++kk) {
                const int d0 = kk * 32 + fq * 8;
                bf16x8 Bs[2];
#pragma unroll
                for (int v2 = 0; v2 < 2; ++v2) { const float* sp = ut + (16 * (2 * wave + v2) + fr) * 128 + d0; const f32x4 a = *(const f32x4*)sp, b = *(const f32x4*)(sp + 4);
                    const float f[8] = {a.x, a.y, a.z, a.w, b.x, b.y, b.z, b.w}; Bs[v2] = pack8(f); }
#pragma unroll
                for (int tt = 0; tt < 4; ++tt) { const int t = 16 * tt + fr;
                    const u32x4 qw = *(const u32x4*)(PROJ + (size_t)(m0 + t) * NPROJ + C_Q + h * 128 + d0); float q[8]; unpack8(qw, q);
                    const f32x4 a = *(const LAS f32x4*)(sB + t * 132 + d0), b = *(const LAS f32x4*)(sB + t * 132 + d0 + 4);
                    const float bt[8] = {a.x, a.y, a.z, a.w, b.x, b.y, b.z, b.w};
#pragma unroll
                    for (int i = 0; i < 8; ++i) q[i] = q[i] * scale * __expf(bt[i]);
                    const bf16x8 Aq = pack8(q);
#pragma unroll
                    for (int v2 = 0; v2 < 2; ++v2) o[tt][v2] = __builtin_amdgcn_mfma_f32_16x16x32_bf16(Aq, Bs[v2], o[tt][v2], 0, 0, 0); }
            }
#pragma unroll
            for (int tt = 0; tt < 4; ++tt)
#pragma unroll
                for (int j = 0; j < 4; ++j) { float p = o[tt][0][j] * o[tt][0][j] + o[tt][1][j] * o[tt][1][j];
                    p += __shfl_xor(p, 1); p += __shfl_xor(p, 2); p += __shfl_xor(p, 4); p += __shfl_xor(p, 8);
                    if (fr == 0) sRS[wave * 64 + 16 * tt + fq * 4 + j] = p; }
            __syncthreads();
            if (tid < 64) { float s = 0.f;
#pragma unroll
                for (int w = 0; w < 8; ++w) s += sRS[w * 64 + tid];
                sR[tid] = rsqrtf(s * (1.0f / 256.0f) + EPS_); }
            __syncthreads();
#pragma unroll
            for (int tt = 0; tt < 4; ++tt)
#pragma unroll
                for (int j = 0; j < 4; ++j) { const int t = 16 * tt + fq * 4 + j; const float rs = sR[t];
#pragma unroll
                    for (int v2 = 0; v2 < 2; ++v2) { const int vc = 16 * (2 * wave + v2) + fr;
                        const float og = bf2f(PROJ[(size_t)(m0 + t) * NPROJ + C_OG + h * 256 + vc]);
                        const float val = o[tt][v2][j] * rs * P.head_gain[vc] * og * sigmoidf_(og);
                        AB[(size_t)(m0 + t) * 2048 + 1024 + h * 256 + vc] = (bf16_t)(pk2(val, 0.f) & 0xffffu); } }
            __syncthreads();
        }
    }
    xcd_barrier(xbar);

    {
        pg8::StaticOrder S; S.init(M_, 2048, G, bid);
        { pg8::Gemm g{Hb, WT_ao, 2048, 1024, M_, 2048, 1024}; Epi<EP_GATE> E{nullptr, 0, PROJ + C_GA, NPROJ, TMP, nullptr}; pg8::gemm_phase(lds, g, S, E); }
        { pg8::Gemm g{Hb + 1024, WT_bo, 2048, 1024, M_, 2048, 1024}; Epi<EP_GATEADD> E{MIX, 2048, PROJ + C_GB, NPROJ, TMP, nullptr}; pg8::gemm_phase(lds, g, S, E); }
    }
    xcd_barrier(xbar);

    {
        pg8::Gemm g{MIX, WT_mix, 2048, 2048, M_, 2048, 2048}; pg8::StaticOrder S; S.init(M_, 2048, G, bid);
        Epi<EP_F32PART> E{Tb, 2048, nullptr, 0, nullptr, PART};
        pg8::gemm_phase(lds, g, S, E);
    }
    xcd_barrier(xbar);

    for (int m = gw; m < M_; m += NGW) row_pass(Tb, PART, P.x, P.out, Hb, P.g_post_mix, P.g_pre_ffn, m, lane);
    xcd_barrier(xbar);

    {
        pg8::Gemm g{Hb, WT_ff1, 2048, 2048, M_, NFF1, 2048}; pg8::StaticOrder S; S.init(M_, NFF1, G, bid);
        Epi<EP_SWIGLU> E{GU, FF_, nullptr, 0, nullptr, nullptr};
        pg8::gemm_phase(lds, g, S, E);
    }
    xcd_barrier(xbar);

    {
        pg8::Gemm g{GU, WT_dn, FF_, FF_, M_, 2048, FF_}; pg8::StaticOrder S; S.init(M_, 2048, G, bid);
        Epi<EP_F32PART> E{Tb, 2048, nullptr, 0, nullptr, PART};
        pg8::gemm_phase(lds, g, S, E);
    }
    xcd_barrier(xbar);

    for (int m = gw; m < M_; m += NGW) row_pass(Tb, PART, P.out, P.out, Hb, P.g_post_ffn, P.g_pre_ple, m, lane);
    xcd_barrier(xbar);

    {
        pg8::StaticOrder S; S.init(M_, 2048, G, bid);
        { pg8::Gemm g{PBF, WT_pp, 256, 256, M_, 2048, 256}; Epi<EP_F32> E{TMP2, 2048, nullptr, 0, nullptr, nullptr}; pg8::gemm_phase(lds, g, S, E); }
        { pg8::Gemm g{Hb, WT_pg, 2048, 2048, M_, 2048, 2048}; Epi<EP_SIGMUL> E{Tb, 2048, TMP2, 2048, nullptr, PART}; pg8::gemm_phase(lds, g, S, E); }
    }
    xcd_barrier(xbar);

    for (int m = gw; m < M_; m += NGW) row_pass(Tb, PART, P.out, P.out, nullptr, P.g_post_ple, nullptr, m, lane);
}

extern "C" void kernel_launch(void* const* d_in, const int* in_sizes, int n_in, void* d_out, int out_size, void* d_ws, size_t ws_size, hipStream_t stream) {
    static int grid_blocks = 0;
    if (grid_blocks == 0) {
        if (n_in != 21 || out_size != M_ * D_ || ws_size < WS_END) { fprintf(stderr, "kernel_launch: unexpected shapes (n_in %d, out %d, ws %zu, need %zu)\n", n_in, out_size, ws_size, (size_t)WS_END); grid_blocks = -1; return; }
        int dev = 0, cus = 0, per_cu = 0;
        (void)hipGetDevice(&dev);
        (void)hipDeviceGetAttribute(&cus, hipDeviceAttributeMultiprocessorCount, dev);
        if (hipFuncSetAttribute((const void*)mega_fwd, hipFuncAttributeMaxDynamicSharedMemorySize, LDS_BYTES) != hipSuccess) { fprintf(stderr, "kernel_launch: hipFuncSetAttribute failed\n"); grid_blocks = -1; return; }
        if (hipOccupancyMaxActiveBlocksPerMultiprocessor(&per_cu, (const void*)mega_fwd, 512, LDS_BYTES) != hipSuccess || per_cu < 1) { fprintf(stderr, "kernel_launch: occupancy query says %d\n", per_cu); grid_blocks = -1; return; }
        grid_blocks = cus;
    }
    if (grid_blocks < 0) return;
    Params p{};
    const float** pp = (const float**)&p;
    for (int i = 0; i < 21; ++i) pp[i] = (const float*)d_in[i];
    p.out = (float*)d_out; p.ws = (unsigned char*)d_ws;
    if (hipMemsetAsync((char*)d_ws + WS_BAR, 0, WS_BAR_BYTES, stream) != hipSuccess) { fprintf(stderr, "kernel_launch: memset failed\n"); return; }
    void* args[] = {&p};
    hipError_t e = hipLaunchCooperativeKernel((const void*)mega_fwd, dim3(grid_blocks), dim3(512), args, LDS_BYTES, stream);
    if (e != hipSuccess) fprintf(stderr, "cooperative launch failed: %s (grid %d)\n", hipGetErrorString(e), grid_blocks);
}
```
